# Optimizing an MI355X kernel written in HIP

```python
import math
import jax, jax.numpy as jnp
from jax import lax
import numpy as np

D_MODEL = 1024
BATCH = 2
SEQ = 8192
DEPTH = 2

GRID_W = 64
CTX_LEN = 256
NORM_EPS = 1e-6
A_HEADS = 4
A_DK = 128
A_DV = 128
A_CONV = 5
A_CHUNK = 64
B_HEADS = 8
B_Q_RANK = 384
B_KV_RANK = 256
B_NOPE = 64
B_ROPE = 32
B_DV = 64
B_QBLOCK = 128
ROPE_THETA = 10000.0
C_HEADS = 16
C_DH = D_MODEL // C_HEADS
WIN_R = 8
WIN_C = 16
D_FF = 2816
N_EXPERTS = 8
TOP_K = 2
D_FF_EXPERT = 3584

N_EVEN = (DEPTH + 1) // 2
N_ODD = DEPTH // 2
IN_SPLITS = (A_HEADS * A_DK, A_HEADS * A_DK, A_HEADS * A_DV, A_HEADS * A_DV, 2 * A_HEADS, 2 * A_HEADS, B_Q_RANK, B_KV_RANK, B_ROPE)
IN_DIM = sum(IN_SPLITS)
MIX_OUT = A_HEADS * A_DV + B_HEADS * B_DV

kernel_name = 'hybrid_gdn_mla_nat_moe_dit'

F32 = jnp.float32


def rmsnorm(x, g):
    xf = x.astype(F32)
    y = xf * lax.rsqrt(jnp.mean(xf * xf, axis=-1, keepdims=True) + NORM_EPS)
    return (y * g.astype(F32)).astype(x.dtype)


def l2norm(x):
    xf = x.astype(F32)
    return (xf * lax.rsqrt(jnp.sum(xf * xf, axis=-1, keepdims=True) + 1e-6)).astype(x.dtype)


def split_cols(t, sizes):
    offs = [int(o) for o in np.cumsum(sizes)[:-1]]
    return jnp.split(t, offs, axis=-1)


def dwconv_centred(x, w):
    k = w.shape[0]
    return lax.conv_general_dilated(x, w[:, None, :].astype(x.dtype), window_strides=(1,), padding=[((k - 1) // 2, (k - 1) // 2)], dimension_numbers=('NWC', 'WIO', 'NWC'), feature_group_count=x.shape[-1])


def axial_rope_tables(L):
    t = jnp.arange(L)
    row = (t // GRID_W).astype(F32)
    col = (t % GRID_W).astype(F32)
    half = B_ROPE // 2
    inv = ROPE_THETA ** (-jnp.arange(0, half, 2, dtype=F32) / half)
    ar = row[:, None] * inv[None, :]
    ac = col[:, None] * inv[None, :]
    ang = jnp.concatenate([ar, ar, ac, ac], axis=-1)
    return jnp.cos(ang), jnp.sin(ang)


def apply_rope(x, cos, sin):
    x1, x2, x3, x4 = jnp.split(x.astype(F32), 4, axis=-1)
    rot = jnp.concatenate([-x2, x1, -x4, x3], axis=-1)
    shp = (cos.shape[0],) + (1,) * (x.ndim - 3) + (cos.shape[1],)
    return (x.astype(F32) * cos.reshape(shp) + rot * sin.reshape(shp)).astype(x.dtype)


def gated_delta_chunked(q, k, v, g, beta, s0):
    b, h, L, dk = q.shape
    dv = v.shape[-1]
    n = L // A_CHUNK

    def blocks(t):
        return t.astype(F32).reshape(b, h, n, A_CHUNK, *t.shape[3:])

    q = blocks(q) * (dk ** -0.5)
    k, v, g, beta = blocks(k), blocks(v), blocks(g), blocks(beta)
    gc = jnp.cumsum(g, axis=-1)
    lower = jnp.tril(jnp.ones((A_CHUNK, A_CHUNK), bool))
    strict = jnp.tril(jnp.ones((A_CHUNK, A_CHUNK), bool), -1)
    diff = gc[..., :, None] - gc[..., None, :]
    decay = jnp.where(lower, jnp.exp(jnp.where(lower, diff, 0.0)), 0.0)
    kb = k * beta[..., None]
    a_mat = jnp.where(strict, jnp.einsum('bhnid,bhnjd->bhnij', kb, k) * decay, 0.0)
    tmat = a_mat + jnp.eye(A_CHUNK, dtype=F32)
    u = lax.linalg.triangular_solve(tmat, v * beta[..., None], left_side=True, lower=True, unit_diagonal=True)
    w = lax.linalg.triangular_solve(tmat, kb * jnp.exp(gc)[..., None], left_side=True, lower=True, unit_diagonal=True)
    qk = jnp.einsum('bhnid,bhnjd->bhnij', q, k) * decay
    qg = q * jnp.exp(gc)[..., None]
    kg = k * jnp.exp(gc[..., -1:] - gc)[..., None]
    g_last = jnp.exp(gc[..., -1])

    def step(s, xs):
        qg_i, kg_i, u_i, w_i, qk_i, gl_i = xs
        v_new = u_i - jnp.einsum('bhid,bhde->bhie', w_i, s)
        o = jnp.einsum('bhid,bhde->bhie', qg_i, s) + jnp.einsum('bhij,bhje->bhie', qk_i, v_new)
        s = s * gl_i[..., None, None] + jnp.einsum('bhid,bhie->bhde', kg_i, v_new)
        return s, o

    xs = (jnp.moveaxis(qg, 2, 0), jnp.moveaxis(kg, 2, 0), jnp.moveaxis(u, 2, 0), jnp.moveaxis(w, 2, 0), jnp.moveaxis(qk, 2, 0), jnp.moveaxis(g_last, 2, 0))
    s_final, o = lax.scan(step, s0, xs)
    return jnp.moveaxis(o, 0, 2).reshape(b, h, L, dv), s_final


def gdn_prepare(q, k, v, a, bg, conv_w, a_log, dt_bias):
    bsz, L, _ = q.shape
    qkv = jax.nn.silu(dwconv_centred(jnp.concatenate([q, k, v], axis=-1), conv_w))
    q, k, v = split_cols(qkv, (A_HEADS * A_DK, A_HEADS * A_DK, A_HEADS * A_DV))
    q = l2norm(q.reshape(bsz, L, A_HEADS, A_DK))
    k = l2norm(k.reshape(bsz, L, A_HEADS, A_DK))
    v = v.reshape(bsz, L, A_HEADS, A_DV)
    a = a.reshape(bsz, L, 2, A_HEADS).astype(F32)
    bg = bg.reshape(bsz, L, 2, A_HEADS).astype(F32)
    g = -jnp.exp(a_log.astype(F32)) * jax.nn.softplus(a + dt_bias.astype(F32))
    beta = jax.nn.sigmoid(bg)
    return (jnp.moveaxis(q, 1, 2), jnp.moveaxis(k, 1, 2), jnp.moveaxis(v, 1, 2), jnp.moveaxis(g, 1, -1), jnp.moveaxis(beta, 1, -1))


def gdn_bidirectional(ctx_in, lat_in):
    qc, kc, vc, gcx, bcx = ctx_in
    ql, kl, vl, glt, blt = lat_in
    s0 = jnp.zeros((qc.shape[0], A_HEADS, A_DK, A_DV), F32)
    fl = lambda t: jnp.flip(t, axis=2)
    oc_f, sc_f = gated_delta_chunked(qc, kc, vc, gcx[:, 0], bcx[:, 0], s0)
    ol_f, _ = gated_delta_chunked(ql, kl, vl, glt[:, 0], blt[:, 0], sc_f)
    oc_b, sc_b = gated_delta_chunked(fl(qc), fl(kc), fl(vc), fl(gcx[:, 1]), fl(bcx[:, 1]), s0)
    ol_b, _ = gated_delta_chunked(fl(ql), fl(kl), fl(vl), fl(glt[:, 1]), fl(blt[:, 1]), sc_b)
    return oc_f + fl(oc_b), ol_f + fl(ol_b)


def gdn_output(o, z, g):
    bsz, H, L, dv = o.shape
    o = rmsnorm(jnp.moveaxis(o, 1, 2), g) * jax.nn.silu(z.reshape(bsz, L, H, dv).astype(F32))
    return o.reshape(bsz, L, H * dv).astype(z.dtype)


def mla_project(cq, ckv, kr, q_g, w_uq, kv_g, w_ukv):
    bsz, L, _ = cq.shape
    q = (rmsnorm(cq, q_g) @ w_uq).reshape(bsz, L, B_HEADS, B_NOPE + B_ROPE)
    kv = (rmsnorm(ckv, kv_g) @ w_ukv).reshape(bsz, L, B_HEADS, B_NOPE + B_DV)
    return q[..., :B_NOPE], q[..., B_NOPE:], kv[..., :B_NOPE], kr, kv[..., B_NOPE:]


def mla_attend(qn, qr, kn, kr, v):
    s = jnp.einsum('bqhd,bkhd->bhqk', qn, kn).astype(F32) + jnp.einsum('bqhr,bkr->bhqk', qr, kr).astype(F32)
    p = jax.nn.softmax(s * ((B_NOPE + B_ROPE) ** -0.5), axis=-1).astype(v.dtype)
    return jnp.einsum('bhqk,bkhd->bqhd', p, v)


def mla_latent_attention(qn, qr, kn, kr, v):
    bsz, L, H, _ = qn.shape
    nb = L // B_QBLOCK
    blk = lambda t: jnp.moveaxis(t.reshape(bsz, nb, B_QBLOCK, *t.shape[2:]), 1, 0)
    o = lax.map(lambda qs: mla_attend(qs[0], qs[1], kn, kr, v), (blk(qn), blk(qr)))
    return jnp.moveaxis(o, 0, 1).reshape(bsz, L, H * B_DV)


def dense_attention(q, k, v):
    s = jnp.einsum('bqhd,bkhd->bhqk', q, k).astype(F32) * (q.shape[-1] ** -0.5)
    p = jax.nn.softmax(s, axis=-1).astype(v.dtype)
    return jnp.einsum('bhqk,bkhd->bqhd', p, v)


def neighbourhood_attention(q, k, v, k_ctx, v_ctx, rpb):
    bsz, L, H, dh = q.shape
    rows = L // GRID_W
    wr = min(WIN_R, rows)
    n_nb = wr * WIN_C
    scale = dh ** -0.5
    qg = q.reshape(bsz, rows, GRID_W, H, dh)
    kg = k.reshape(bsz, rows, GRID_W, H, dh)
    vg = v.reshape(bsz, rows, GRID_W, H, dh)
    col = jnp.arange(GRID_W)
    col_idx = jnp.clip(col - WIN_C // 2, 0, GRID_W - WIN_C)[:, None] + jnp.arange(WIN_C)[None, :]
    dc_idx = col_idx - col[:, None] + (WIN_C - 1)

    def row_block(r):
        r0 = jnp.clip(r - wr // 2, 0, rows - wr)
        k_win = lax.dynamic_slice_in_dim(kg, r0, wr, axis=1)[:, :, col_idx]
        v_win = lax.dynamic_slice_in_dim(vg, r0, wr, axis=1)[:, :, col_idx]
        q_r = lax.dynamic_index_in_dim(qg, r, axis=1, keepdims=False)
        dr_idx = r0 + jnp.arange(wr) - r + (WIN_R - 1)
        bias = rpb[:, dr_idx[None, :, None], dc_idx[:, None, :]].astype(F32)
        s_nb = jnp.einsum('bqhd,brqwhd->bhqrw', q_r, k_win).astype(F32) * scale + bias
        s_ctx = jnp.einsum('bqhd,bkhd->bhqk', q_r, k_ctx).astype(F32) * scale
        s = jnp.concatenate([s_nb.reshape(bsz, H, GRID_W, n_nb), s_ctx], axis=-1)
        p = jax.nn.softmax(s, axis=-1).astype(v.dtype)
        p_nb = p[..., :n_nb].reshape(bsz, H, GRID_W, wr, WIN_C)
        return jnp.einsum('bhqrw,brqwhd->bqhd', p_nb, v_win) + jnp.einsum('bhqk,bkhd->bqhd', p[..., n_nb:], v_ctx)

    o = lax.map(row_block, jnp.arange(rows))
    return jnp.moveaxis(o, 0, 1).reshape(bsz, L, H, dh)


def even_mixer(h_c, h_l, cos, sin, need_ctx, w_in, conv_w, a_log, dt_bias, gdn_g, q_g, w_uq, kv_g, w_ukv, w_out):
    pc = split_cols(h_c @ w_in, IN_SPLITS)
    pl = split_cols(h_l @ w_in, IN_SPLITS)
    a_ctx = gdn_prepare(pc[0], pc[1], pc[2], pc[4], pc[5], conv_w, a_log, dt_bias)
    a_lat = gdn_prepare(pl[0], pl[1], pl[2], pl[4], pl[5], conv_w, a_log, dt_bias)
    oa_c, oa_l = gdn_bidirectional(a_ctx, a_lat)
    ya_l = gdn_output(oa_l, pl[3], gdn_g)
    qn_c, qr_c, kn_c, kr_c, v_c = mla_project(pc[6], pc[7], pc[8], q_g, w_uq, kv_g, w_ukv)
    qn_l, qr_l, kn_l, kr_l, v_l = mla_project(pl[6], pl[7], pl[8], q_g, w_uq, kv_g, w_ukv)
    qr_l = apply_rope(qr_l, cos, sin)
    kr_l = apply_rope(kr_l, cos, sin)
    yb_l = mla_latent_attention(qn_l, qr_l, jnp.concatenate([kn_c, kn_l], axis=1), jnp.concatenate([kr_c, kr_l], axis=1), jnp.concatenate([v_c, v_l], axis=1))
    out_l = jnp.concatenate([ya_l, yb_l], axis=-1) @ w_out
    out_c = None
    if need_ctx:
        bsz, Lc, _ = h_c.shape
        ya_c = gdn_output(oa_c, pc[3], gdn_g)
        yb_c = mla_attend(qn_c, qr_c, kn_c, kr_c, v_c).reshape(bsz, Lc, B_HEADS * B_DV)
        out_c = jnp.concatenate([ya_c, yb_c], axis=-1) @ w_out
    return out_c, out_l


def odd_mixer(h_c, h_l, need_ctx, w_qkv, rpb, w_out):
    bsz, L, D = h_l.shape
    Lc = h_c.shape[1]
    q_l, k_l, v_l = [t.reshape(bsz, L, C_HEADS, C_DH) for t in jnp.split(h_l @ w_qkv, 3, axis=-1)]
    q_c, k_c, v_c = [t.reshape(bsz, Lc, C_HEADS, C_DH) for t in jnp.split(h_c @ w_qkv, 3, axis=-1)]
    out_l = neighbourhood_attention(q_l, k_l, v_l, k_c, v_c, rpb).reshape(bsz, L, D) @ w_out
    out_c = None
    if need_ctx:
        out_c = dense_attention(q_c, k_c, v_c).reshape(bsz, Lc, D) @ w_out
    return out_c, out_l


def swiglu(h, wg, wu, wd):
    return (jax.nn.silu(h @ wg) * (h @ wu)) @ wd


def moe_swiglu(h, w_router, wg, wu, wd):
    shp = h.shape
    t = h.reshape(-1, shp[-1])
    logits = (t @ w_router).astype(F32)
    top_v, top_i = lax.top_k(logits, TOP_K)
    gates = jax.nn.softmax(top_v, axis=-1)
    out = jnp.zeros_like(t)
    for e in range(N_EXPERTS):
        w_e = jnp.sum(jnp.where(top_i == e, gates, 0.0), axis=-1).astype(t.dtype)
        out = out + w_e[:, None] * swiglu(t, wg[e], wu[e], wd[e])
    return out.reshape(shp)


def setup_inputs(seed: int = 0) -> dict:
    key = jax.random.key(seed)
    ks = iter(list(jax.random.split(key, 40)))
    D = D_MODEL
    nrm = lambda shape, scale: jax.random.normal(next(ks), shape, F32) * scale
    gain = lambda shape: 1.0 + 0.02 * jax.random.normal(next(ks), shape, F32)
    dt = jnp.exp(jax.random.uniform(next(ks), (N_EVEN, 2, A_HEADS), F32, math.log(1e-3), math.log(1e-1)))
    return {
        'x': nrm((BATCH, SEQ, D), 1.0),
        'c': nrm((BATCH, D), 1.0),
        'ctx': nrm((BATCH, CTX_LEN, D), 1.0),
        'c_ctx': nrm((D,), 1.0),
        'ada_w': nrm((DEPTH, D, 6 * D), 0.5 * D ** -0.5),
        'ada_b': nrm((DEPTH, 6 * D), 0.01),
        'norm_g': gain((DEPTH, 2, D)),
        'ev_w_in': nrm((N_EVEN, D, IN_DIM), D ** -0.5),
        'ev_conv_w': nrm((N_EVEN, A_CONV, 2 * A_HEADS * A_DK + A_HEADS * A_DV), A_CONV ** -0.5),
        'ev_a_log': jnp.log(jax.random.uniform(next(ks), (N_EVEN, 2, A_HEADS), F32, 1.0, 16.0)),
        'ev_dt_bias': dt + jnp.log(-jnp.expm1(-dt)),
        'ev_gdn_norm_g': gain((N_EVEN, A_DV)),
        'ev_q_norm_g': gain((N_EVEN, B_Q_RANK)),
        'ev_w_uq': nrm((N_EVEN, B_Q_RANK, B_HEADS * (B_NOPE + B_ROPE)), B_Q_RANK ** -0.5),
        'ev_kv_norm_g': gain((N_EVEN, B_KV_RANK)),
        'ev_w_ukv': nrm((N_EVEN, B_KV_RANK, B_HEADS * (B_NOPE + B_DV)), B_KV_RANK ** -0.5),
        'ev_w_out': nrm((N_EVEN, MIX_OUT, D), MIX_OUT ** -0.5),
        'ev_ffn_wg': nrm((N_EVEN, D, D_FF), D ** -0.5),
        'ev_ffn_wu': nrm((N_EVEN, D, D_FF), D ** -0.5),
        'ev_ffn_wd': nrm((N_EVEN, D_FF, D), D_FF ** -0.5),
        'od_w_qkv': nrm((N_ODD, D, 3 * D), D ** -0.5),
        'od_rpb': nrm((N_ODD, C_HEADS, 2 * WIN_R - 1, 2 * WIN_C - 1), 0.1),
        'od_w_out': nrm((N_ODD, D, D), D ** -0.5),
        'od_router': nrm((N_ODD, D, N_EXPERTS), D ** -0.5),
        'od_exp_wg': nrm((N_ODD, N_EXPERTS, D, D_FF_EXPERT), D ** -0.5),
        'od_exp_wu': nrm((N_ODD, N_EXPERTS, D, D_FF_EXPERT), D ** -0.5),
        'od_exp_wd': nrm((N_ODD, N_EXPERTS, D_FF_EXPERT, D), D_FF_EXPERT ** -0.5),
        'final_norm_g': gain((D,)),
    }


def reference(x, c, ctx, c_ctx, ada_w, ada_b, norm_g, ev_w_in, ev_conv_w, ev_a_log, ev_dt_bias, ev_gdn_norm_g, ev_q_norm_g, ev_w_uq, ev_kv_norm_g, ev_w_ukv, ev_w_out, ev_ffn_wg, ev_ffn_wu, ev_ffn_wd, od_w_qkv, od_rpb, od_w_out, od_router, od_exp_wg, od_exp_wu, od_exp_wd, final_norm_g):
    L = x.shape[1]
    cos, sin = axial_rope_tables(L)
    s_c = jax.nn.silu(c)
    s_cc = jax.nn.silu(c_ctx)
    x_l, x_c = x, ctx
    for i in range(DEPTH):
        need_ctx = i < DEPTH - 1
        j = i // 2
        mod_l = (s_c @ ada_w[i] + ada_b[i])[:, None, :]
        mod_c = (s_cc @ ada_w[i] + ada_b[i])[None, None, :]
        sh1_l, sc1_l, g1_l, sh2_l, sc2_l, g2_l = jnp.split(mod_l, 6, axis=-1)
        sh1_c, sc1_c, g1_c, sh2_c, sc2_c, g2_c = jnp.split(mod_c, 6, axis=-1)
        h_l = rmsnorm(x_l, norm_g[i, 0]) * (1.0 + sc1_l) + sh1_l
        h_c = rmsnorm(x_c, norm_g[i, 0]) * (1.0 + sc1_c) + sh1_c
        if i % 2 == 0:
            out_c, out_l = even_mixer(h_c, h_l, cos, sin, need_ctx, ev_w_in[j], ev_conv_w[j], ev_a_log[j], ev_dt_bias[j], ev_gdn_norm_g[j], ev_q_norm_g[j], ev_w_uq[j], ev_kv_norm_g[j], ev_w_ukv[j], ev_w_out[j])
        else:
            out_c, out_l = odd_mixer(h_c, h_l, need_ctx, od_w_qkv[j], od_rpb[j], od_w_out[j])
        x_l = x_l + g1_l * out_l
        f_l = rmsnorm(x_l, norm_g[i, 1]) * (1.0 + sc2_l) + sh2_l
        if i % 2 == 0:
            x_l = x_l + g2_l * swiglu(f_l, ev_ffn_wg[j], ev_ffn_wu[j], ev_ffn_wd[j])
        else:
            x_l = x_l + g2_l * moe_swiglu(f_l, od_router[j], od_exp_wg[j], od_exp_wu[j], od_exp_wd[j])
        if need_ctx:
            x_c = x_c + g1_c * out_c
            f_c = rmsnorm(x_c, norm_g[i, 1]) * (1.0 + sc2_c) + sh2_c
            if i % 2 == 0:
                x_c = x_c + g2_c * swiglu(f_c, ev_ffn_wg[j], ev_ffn_wu[j], ev_ffn_wd[j])
            else:
                x_c = x_c + g2_c * moe_swiglu(f_c, od_router[j], od_exp_wg[j], od_exp_wu[j], od_exp_wd[j])
    return rmsnorm(x_l, final_norm_g)
```

```cpp
#include <hip/hip_runtime.h>
#include <stdint.h>
#include <stdio.h>

#define GAS __attribute__((address_space(1)))
#define LAS __attribute__((address_space(3)))
typedef unsigned short bf16_t;
typedef short bf16x8 __attribute__((ext_vector_type(8)));
typedef short s16x4 __attribute__((ext_vector_type(4)));
typedef float f32x4 __attribute__((ext_vector_type(4)));
typedef float f32x2 __attribute__((ext_vector_type(2)));
typedef float f32x16 __attribute__((ext_vector_type(16)));
typedef unsigned u32x4 __attribute__((ext_vector_type(4)));
typedef unsigned u32x2 __attribute__((ext_vector_type(2)));
#define DI __device__ __forceinline__

constexpr int D = 1024, NB = 2, SEQ = 8192, LC = 256;
constexpr int ML = NB * SEQ;
constexpr int MC = NB * LC;
constexpr int MT = ML + MC;
constexpr int NPROJ = 2816;
constexpr int DFF = 2816, DFE = 3584, NE = 8;
constexpr int MOE_ROWS = 34816;
constexpr int NCHUNK = 132;
constexpr float EPS = 1e-6f;

constexpr size_t MiB = 1u << 20;
constexpr size_t WS_CTL = 0, CTL_BYTES = 1 * MiB;
constexpr size_t WS_MOD = 1 * MiB;
constexpr size_t WS_ROPE = 2 * MiB;
constexpr size_t WS_GB = 3 * MiB;
constexpr size_t WS_AB = 5 * MiB;
constexpr size_t WS_ROUTE = 7 * MiB;
constexpr size_t WS_XC = 8 * MiB;
constexpr size_t WS_GC = 10 * MiB;
constexpr size_t WS_KR = 11 * MiB;
constexpr size_t WS_WQK1 = 16 * MiB;
constexpr size_t WS_WO1 = 22 * MiB;
constexpr size_t WS_WEGU = 24 * MiB;
constexpr size_t WS_WED = 136 * MiB;
constexpr size_t WS_WIN = 192 * MiB;
constexpr size_t WS_WUQ = WS_WIN + (size_t)NPROJ * D * 2;
constexpr size_t WS_WUKV = WS_WUQ + (size_t)768 * 384 * 2;
constexpr size_t WS_WO0 = WS_WUKV + (size_t)1024 * 256 * 2;
constexpr size_t WS_WGU = WS_WO0 + (size_t)D * D * 2;
constexpr size_t WS_WD = WS_WGU + (size_t)2 * DFF * D * 2;
static_assert(WS_WD + (size_t)D * DFF * 2 <= 218 * MiB, "L0 weights");
constexpr size_t WS_H = 218 * MiB;
constexpr size_t WS_QKVP = WS_H + (size_t)MT * D * 2;
constexpr size_t WS_CQKV = WS_QKVP + (size_t)MT * 1536 * 2;
constexpr size_t WS_Z = WS_CQKV + (size_t)MT * 768 * 2;
constexpr size_t WS_QKVC = WS_Z + (size_t)MT * 512 * 2;
constexpr size_t WS_GU = WS_QKVC + (size_t)MT * 1536 * 2;
constexpr size_t WS_GW = WS_GU + (size_t)2112 * 64 * 128 * 2;
constexpr size_t WS_GQK = WS_GW + (size_t)2112 * 64 * 128 * 2;
constexpr size_t WS_KN = WS_GQK + (size_t)2112 * 64 * 64 * 2;
constexpr size_t WS_VT = WS_KN + (size_t)MT * 512 * 2;
constexpr size_t WS_L0_END = WS_VT + (size_t)MT * 512 * 2;
constexpr size_t WS_MLAQ = WS_QKVP;
constexpr size_t WS_OFB = WS_MLAQ + (size_t)MT * 768 * 2;
static_assert(WS_OFB + (size_t)2 * MT * 512 * 2 <= WS_Z, "OFB overlay");
constexpr size_t WS_ACT = WS_QKVP;
constexpr size_t WS_XLB = 384 * MiB;
constexpr size_t WS_PART = WS_QKVC;
static_assert(WS_ACT + (size_t)MT * DFF * 2 <= WS_QKVC, "ACT overlay");
constexpr size_t WS_QK1 = WS_QKVP;
constexpr size_t WS_VT1 = WS_QK1 + (size_t)MT * 2048 * 2;
constexpr size_t WS_O1 = WS_VT1 + (size_t)MT * 1024 * 2;
constexpr size_t WS_F = 192 * MiB;
constexpr size_t WS_ACTS = 192 * MiB;
constexpr size_t WS_FS = WS_ACTS + (size_t)MOE_ROWS * DFE * 2;
constexpr size_t WS_PARTY = WS_FS + (size_t)MOE_ROWS * D * 2;
constexpr size_t WS_L1_END = WS_PARTY + (size_t)4 * 2048 * 1024 * 2;
constexpr size_t WS_END = (WS_L0_END > WS_L1_END ? WS_L0_END : WS_L1_END);
static_assert(WS_O1 + (size_t)ML * D * 2 <= WS_END && WS_END <= 541046912ull, "d_ws map must fit sum(inputs) bytes");

constexpr int CW_BAR = 4096;
constexpr int CW_ECNT = 8192;
constexpr int CW_QUEUE = 9216;
constexpr int CW_SCANDONE = 11264;
constexpr int CW_GOQ = 11328;
constexpr int CW_GDNQ = 10496;

constexpr int LDS_BYTES = 147456;
constexpr int MISC_OFF = LDS_BYTES - 512;

DI unsigned f2bf(float f) { unsigned u = __builtin_bit_cast(unsigned, f); return (u + 0x7fffu + ((u >> 16) & 1u)) >> 16; }
DI unsigned pk2(float lo, float hi) { return f2bf(lo) | (f2bf(hi) << 16); }
DI float bf2f(unsigned short b) { return __builtin_bit_cast(float, ((unsigned)b) << 16); }
DI float bflo(unsigned u) { return __builtin_bit_cast(float, u << 16); }
DI float bfhi(unsigned u) { return __builtin_bit_cast(float, u & 0xffff0000u); }
DI float wave_sum(float v) {
#pragma unroll
    for (int o = 1; o < 64; o <<= 1) v += __shfl_xor(v, o);
    return v;
}
DI float siluf(float x) { return x * __builtin_amdgcn_rcpf(1.f + __expf(-x)); }
DI float sigmoidf(float x) { return __builtin_amdgcn_rcpf(1.f + __expf(-x)); }
#define LDS_WAIT() asm volatile("s_waitcnt lgkmcnt(0)" ::: "memory")

#define XB_TMO      128
#define XB_XCNT(j)  (256  + 64 * (j))
#define XB_XSUB(j)  (1280 + 64 * (j))
#define XB_XGEN(j)  (2304 + 64 * (j))
#define XB_TOP      3328
#define XB_TOPGEN   3392
#define XCD_BAR_WORDS 3456
#define XB_SPIN_CAP (1u << 20)
DI unsigned xb_ld(unsigned* p)              { return __hip_atomic_load(p, __ATOMIC_RELAXED, __HIP_MEMORY_SCOPE_AGENT); }
DI unsigned xb_add(unsigned* p, unsigned v) { return __hip_atomic_fetch_add(p, v, __ATOMIC_RELAXED, __HIP_MEMORY_SCOPE_AGENT); }
DI unsigned xb_xcc_id() { return (unsigned)__builtin_amdgcn_s_getreg((3 << 11) | 20) & 0xFu; }
#define XB_SPIN(cond, bar) do { unsigned _sp = 0; while (cond) { __builtin_amdgcn_s_sleep(1); \
    if ((++_sp & 255u) == 0u) { if (xb_ld(&(bar)[XB_TMO])) break; if (_sp > XB_SPIN_CAP) { atomicAdd(&(bar)[XB_TMO], 1u); break; } } } } while (0)
struct XcdBarrier { unsigned* bar; unsigned x; volatile LAS unsigned* st; };
DI XcdBarrier xcd_barrier_post(unsigned* bar, volatile LAS unsigned* st) {
    XcdBarrier b; b.bar = bar; b.x = xb_xcc_id(); b.st = st;
    if (threadIdx.x == 0) (void)xb_add(&bar[XB_XCNT(b.x)], 1u);
    return b;
}
DI void xcd_barrier_complete(unsigned* bar, unsigned x, unsigned& nloc, unsigned& nx) {
    const unsigned G = gridDim.x * gridDim.y * gridDim.z;
    unsigned sum, cnt, mine, sp = 0u;
    for (;;) {
        sum = 0u; cnt = 0u; mine = 0u;
#pragma unroll
        for (unsigned j = 0; j < 16; ++j) { const unsigned c = xb_ld(&bar[XB_XCNT(j)]); sum += c; cnt += (c > 0u) ? 1u : 0u; mine = (j == x) ? c : mine; }
        if (sum == G) break;
        __builtin_amdgcn_s_sleep(1);
        if ((++sp & 255u) == 0u) { if (xb_ld(&bar[XB_TMO])) break; if (sp > XB_SPIN_CAP) { atomicAdd(&bar[XB_TMO], 1u); break; } }
    }
    nloc = mine > 0u ? mine : 1u; nx = cnt > 0u ? cnt : 1u;
}
DI void xcd_barrier(const XcdBarrier& b) {
    asm volatile("s_waitcnt vmcnt(0)" ::: "memory");
    __syncthreads();
    if (threadIdx.x == 0) {
        unsigned* bar = b.bar;
        __builtin_amdgcn_s_waitcnt(0);
        unsigned nloc = b.st[0], nx = b.st[1];
        if (nloc == 0u) { xcd_barrier_complete(bar, b.x, nloc, nx); b.st[0] = nloc; b.st[1] = nx; }
        const unsigned old = xb_add(&bar[XB_XSUB(b.x)], 1u);
        const unsigned gen = old / nloc;
        if (old + 1u == (gen + 1u) * nloc) {
            __builtin_amdgcn_fence(__ATOMIC_RELEASE, "agent");
            asm volatile("s_waitcnt vmcnt(0)" ::: "memory");
            const unsigned og = xb_add(&bar[XB_TOP], 1u);
            const unsigned tg = og / nx;
            if (og + 1u == (tg + 1u) * nx) xb_add(&bar[XB_TOPGEN], 1u);
            else XB_SPIN(xb_ld(&bar[XB_TOPGEN]) == tg, bar);
            __builtin_amdgcn_fence(__ATOMIC_ACQUIRE, "agent");
            xb_add(&bar[XB_XGEN(b.x)], 1u);
            asm volatile("s_waitcnt vmcnt(0)" ::: "memory");
        } else {
            XB_SPIN(xb_ld(&bar[XB_XGEN(b.x)]) == gen, bar);
            __builtin_amdgcn_fence(__ATOMIC_ACQUIRE, "agent");
            asm volatile("s_waitcnt vmcnt(0)" ::: "memory");
        }
    }
    __syncthreads();
}

namespace pg8 {
constexpr int BM = 256, BK = 64, HALF = 128, HTB = HALF * BK * 2, STAGE_BYTES = 8 * HTB, NXCD = 8, WGM = 8;
__host__ __device__ __forceinline__ int lds_byte(int r, int c) { const int st = (r >> 4) * 2 + (c >> 5), rr = r & 15, cc = c & 31, ob = rr * 64 + cc * 2; return st * 1024 + (ob ^ (((ob >> 9) & 1) << 5)); }
__host__ __device__ __forceinline__ void stage_rc(int b, int& R, int& C) { const int st = b / 1024, sb = b % 1024, swz = sb ^ (((sb >> 9) & 1) << 5); R = (st >> 1) * 16 + swz / 64; C = (st & 1) * 32 + (swz % 64) / 2; }
__host__ __device__ __forceinline__ int perm32(int rho) { const int n = rho >> 4, i = rho & 15; return 8 * (i >> 2) + 4 * n + (i & 3); }
struct Unit { int pm, pn, e, kb; };
struct Gemm { const bf16_t* A; const bf16_t* Bt; int lda, ldb, K; size_t bstride, astride; };
struct StaticOrder {
    int nM, nN, nwg, G, c;
    __device__ void init(int M, int N, int G_, int c_) { nM = M / BM; nN = N / BM; nwg = nM * nN; G = G_; c = c_; }
    __device__ bool next(int i, Unit& u) const {
        const long L = (long)i * G + c; if (L >= nwg) return false;
        int wgid = (int)L; { const int q = nwg / NXCD, r = nwg % NXCD, xcd = wgid % NXCD, off = wgid / NXCD; wgid = (xcd < r ? xcd * (q + 1) : r * (q + 1) + (xcd - r) * q) + off; }
        const int nig = WGM * nN, gid = wgid / nig, fm = gid * WGM, gsz = (nM - fm) < WGM ? (nM - fm) : WGM;
        u.pm = fm + ((wgid % nig) % gsz); u.pn = (wgid % nig) / gsz; u.e = 0; u.kb = 0; return true;
    }
};
struct MoeOrder : StaticOrder {
    int te[9];
    __device__ void init_moe(const unsigned* cnt, int N, int G_, int c_) {
        int t = 0;
#pragma unroll
        for (int e = 0; e < 8; ++e) { te[e] = t; t += (__builtin_amdgcn_readfirstlane((int)cnt[64 * e]) + 255) >> 8; }
        te[8] = t; nM = t; nN = N / BM; nwg = nM * nN; G = G_; c = c_;
    }
    __device__ bool next(int i, Unit& u) const {
        if (!StaticOrder::next(i, u)) return false;
        int e = 0;
#pragma unroll
        for (int k = 1; k < 8; ++k) e += (u.pm >= te[k]) ? 1 : 0;
        u.e = e; return true;
    }
};
struct SplitKOrder {
    int nsub, G, c;
    __device__ void init(int ks, int G_, int c_) { nsub = ks * 8; G = G_; c = c_; }
    __device__ bool next(int i, Unit& u) const { const int L = i * G + c; if (L >= nsub) return false; u.e = L >> 3; u.pm = (L >> 2) & 1; u.pn = L & 3; u.kb = 0; return true; }
};
struct MoeDownOrder : MoeOrder {
    int mt0, nfull;
    __device__ void init_down(const unsigned* cnt, int G_, int c_) {
        init_moe(cnt, 1024, G_, c_);
        const int units = nM * 4, R = units / G_;
        nfull = ((R * G_) & 3) == 0 ? R * G_ : units;
        mt0 = nfull >> 2;
    }
    __device__ int expert_of(int pm) const { int e = 0;
#pragma unroll
        for (int k = 1; k < 8; ++k) e += (pm >= te[k]) ? 1 : 0;
        return e; }
    __device__ bool next(int i, Unit& u) const { const int L = i * G + c; if (L >= nfull) return false; u.pm = L >> 2; u.pn = L & 3; u.e = expert_of(u.pm); u.kb = 0; return true; }
};
struct MoeTailOrder : MoeDownOrder {
    __device__ bool next(int i, Unit& u) const { const int L = i * G + c; if (L >= (nM - mt0) * 8) return false;
        u.pm = mt0 + (L >> 3); u.pn = (L >> 1) & 3; u.kb = (L & 1) * 1792; u.e = expert_of(u.pm); return true; }
};
DI unsigned cvt_pk_bf16(float lo, float hi) { unsigned r; asm volatile("v_cvt_pk_bf16_f32 %0, %1, %2" : "=v"(r) : "v"(lo), "v"(hi)); return r; }

typedef int i32x4 __attribute__((ext_vector_type(4)));
typedef int i32x8 __attribute__((ext_vector_type(8)));
DI i32x8 cat32(bf16x8 a, bf16x8 b) { return __builtin_shufflevector(__builtin_bit_cast(i32x4, a), __builtin_bit_cast(i32x4, b), 0, 1, 2, 3, 4, 5, 6, 7); }
template <bool FP8 = false, bool ALIGN = false, class Epi, class Sched>
DI void gemm_phase(LAS unsigned char* lds, const Gemm g, const Sched& S, const Epi& E) {
    int tid = threadIdx.x;
    asm volatile("" : "+v"(tid));
    const int wid = __builtin_amdgcn_readfirstlane(tid >> 6), lane = tid & 63, wr = wid >> 2, wc = wid & 3, fr = lane & 15, fq = lane >> 4;
    constexpr int ES = FP8 ? 1 : 2;
    const int K = g.K, nt = K * ES / 128;
    unsigned voffA[2], voffB[2];
#pragma unroll
    for (int i = 0; i < 2; ++i) { int R, C; stage_rc(tid * 16 + i * 8192, R, C); const int Rb = Epi::PERM ? ((R & ~31) + perm32(R & 31)) : R;
        voffA[i] = (unsigned)(R * g.lda * ES + C * 2); voffB[i] = (unsigned)(Rb * g.ldb * ES + C * 2); }
    const size_t kstep = (size_t)(BK * 2);
    const size_t hstepA = (size_t)HALF * g.lda * ES, hstepB = (size_t)HALF * g.ldb * ES;
    const size_t tstepA = 2 * hstepA, tstepB = 2 * hstepB;
    const unsigned ldsw = (unsigned)wid * 1024u;
    const int aoff = lds_byte(wr * 64 + fr, fq * 8), boff = lds_byte(wc * 32 + fr, fq * 8);
#define PG8_SA(b, h) (((b) * 2 + (h)) * HTB)
#define PG8_SB(b, h) ((4 + (b) * 2 + (h)) * HTB)
#define PG8_STAGE(bufoff, gbase, voff) do { _Pragma("unroll") for (int _i = 0; _i < 2; ++_i) \
        __builtin_amdgcn_global_load_lds((const unsigned*)((const char*)(gbase) + (voff)[_i]), (LAS unsigned*)(lds + (bufoff) + ldsw + _i * 8192), 16, 0, 0); } while (0)
#define PG8_LDA(dst, b, h) do { _Pragma("unroll") for (int m = 0; m < 4; ++m) { if constexpr (FP8) dst##8[m] = cat32(*(const LAS bf16x8*)(lds + PG8_SA(b, h) + aoff + m * 2048), *(const LAS bf16x8*)(lds + PG8_SA(b, h) + aoff + m * 2048 + 1024)); \
        else { _Pragma("unroll") for (int k = 0; k < 2; ++k) dst[m][k] = *(const LAS bf16x8*)(lds + PG8_SA(b, h) + aoff + m * 2048 + k * 1024); } } } while (0)
#define PG8_LDB(dst, b, h) do { _Pragma("unroll") for (int n = 0; n < 2; ++n) { if constexpr (FP8) dst##8[n] = cat32(*(const LAS bf16x8*)(lds + PG8_SB(b, h) + boff + n * 2048), *(const LAS bf16x8*)(lds + PG8_SB(b, h) + boff + n * 2048 + 1024)); \
        else { _Pragma("unroll") for (int k = 0; k < 2; ++k) dst[n][k] = *(const LAS bf16x8*)(lds + PG8_SB(b, h) + boff + n * 2048 + k * 1024); } } } while (0)
#define PG8_MMA(ai, bj, At, Bt) do { __builtin_amdgcn_s_setprio(1); _Pragma("unroll") for (int m = 0; m < 4; ++m) _Pragma("unroll") for (int n = 0; n < 2; ++n) { \
        if constexpr (FP8) asm volatile("v_mfma_f32_16x16x128_f8f6f4 %0, %1, %2, %0" : "+v"(acc[ai][bj][m][n]) : "v"(Bt##8[n]), "v"(At##8[m])); \
        else { _Pragma("unroll") for (int k = 0; k < 2; ++k) acc[ai][bj][m][n] = __builtin_amdgcn_mfma_f32_16x16x32_bf16(Bt[n][k], At[m][k], acc[ai][bj][m][n], 0, 0, 0); } } __builtin_amdgcn_s_setprio(0); } while (0)
#define PG8_WAIT_V(n) asm volatile("s_waitcnt vmcnt(" #n ")" ::: "memory")
#define PG8_WAIT_L(n) asm volatile("s_waitcnt lgkmcnt(" #n ")" ::: "memory")
#define PG8_BAR __builtin_amdgcn_s_barrier()
#define PG8_SCHED __builtin_amdgcn_sched_barrier(0)
    Unit cur, nxt; int ui = 0;
    if (!S.next(0, cur)) return;
    f32x4 acc[2][2][4][2];
#pragma unroll
    for (int a = 0; a < 2; ++a)
#pragma unroll
        for (int b = 0; b < 2; ++b)
#pragma unroll
            for (int m = 0; m < 4; ++m)
#pragma unroll
                for (int n = 0; n < 2; ++n) acc[a][b][m][n] = (f32x4){0.f, 0.f, 0.f, 0.f};
    bf16x8 At[4][2], B0[2][2], B1[2][2];
    i32x8 At8[4], B08[2], B18[2];
    const char* cA = (const char*)g.A + (size_t)cur.e * g.astride + (size_t)cur.pm * tstepA + cur.kb; const char* cB = (const char*)g.Bt + (size_t)cur.e * g.bstride + (size_t)cur.pn * tstepB + cur.kb;
    PG8_STAGE(PG8_SB(0, 0), cB, voffB); PG8_STAGE(PG8_SA(0, 0), cA, voffA); PG8_STAGE(PG8_SB(0, 1), cB + hstepB, voffB); PG8_STAGE(PG8_SA(0, 1), cA + hstepA, voffA);
    if (wr == 1) PG8_BAR;
    PG8_WAIT_V(4); PG8_BAR;
    PG8_STAGE(PG8_SB(1, 0), cB + kstep, voffB); PG8_STAGE(PG8_SA(1, 0), cA + kstep, voffA); PG8_STAGE(PG8_SB(1, 1), cB + hstepB + kstep, voffB);
    PG8_WAIT_V(6); PG8_BAR;
    for (;;) {
        const bool has_next = S.next(ui + 1, nxt);
        const char* nA = has_next ? (const char*)g.A + (size_t)nxt.e * g.astride + (size_t)nxt.pm * tstepA + nxt.kb : cA; const char* nB = has_next ? (const char*)g.Bt + (size_t)nxt.e * g.bstride + (size_t)nxt.pn * tstepB + nxt.kb : cB;
        for (int t = 0; t < nt; t += 2) {
            const bool last = (t == nt - 2);
            const char* a1 = cA + (size_t)(t + 1) * kstep;
            const char* a2 = last ? nA : cA + (size_t)(t + 2) * kstep; const char* b2 = last ? nB : cB + (size_t)(t + 2) * kstep;
            const char* a3 = a2 + kstep; const char* b3 = b2 + kstep;
            PG8_LDB(B0, 0, 0); PG8_SCHED; PG8_LDA(At, 0, 0); PG8_STAGE(PG8_SA(1, 1), a1 + hstepA, voffA);
            PG8_WAIT_L(8); PG8_BAR; PG8_WAIT_L(0); PG8_MMA(0, 0, At, B0); PG8_BAR; PG8_SCHED;
            PG8_LDB(B1, 0, 1); PG8_STAGE(PG8_SB(0, 0), b2, voffB);
            PG8_BAR; PG8_WAIT_L(0); PG8_MMA(0, 1, At, B1); PG8_BAR;
            PG8_LDA(At, 0, 1); PG8_STAGE(PG8_SA(0, 0), a2, voffA);
            PG8_BAR; PG8_WAIT_L(0); PG8_MMA(1, 0, At, B0); PG8_BAR; PG8_SCHED;
            PG8_STAGE(PG8_SB(0, 1), b2 + hstepB, voffB);
            PG8_WAIT_V(6); PG8_BAR; PG8_MMA(1, 1, At, B1); PG8_BAR;
            PG8_LDB(B0, 1, 0); PG8_SCHED; PG8_LDA(At, 1, 0); PG8_STAGE(PG8_SA(0, 1), a2 + hstepA, voffA);
            PG8_WAIT_L(8); PG8_BAR; PG8_WAIT_L(0); PG8_MMA(0, 0, At, B0); PG8_BAR; PG8_SCHED;
            PG8_LDB(B1, 1, 1); PG8_STAGE(PG8_SB(1, 0), b3, voffB);
            PG8_BAR; PG8_WAIT_L(0); PG8_MMA(0, 1, At, B1); PG8_BAR;
            PG8_LDA(At, 1, 1); PG8_STAGE(PG8_SA(1, 0), a3, voffA);
            PG8_BAR; PG8_WAIT_L(0); PG8_MMA(1, 0, At, B0); PG8_BAR; PG8_SCHED;
            PG8_STAGE(PG8_SB(1, 1), b3 + hstepB, voffB);
            PG8_WAIT_V(6); PG8_BAR; PG8_MMA(1, 1, At, B1); PG8_BAR;
        }
        if constexpr (ALIGN) if (wr == 0) PG8_BAR;
        if constexpr (FP8) asm volatile("s_nop 15\n\ts_nop 15" ::: "memory");
        E(acc, cur, wr, wc, fr, fq);
        if (!has_next) break;
#pragma unroll
        for (int a = 0; a < 2; ++a)
#pragma unroll
            for (int b = 0; b < 2; ++b)
#pragma unroll
                for (int m = 0; m < 4; ++m)
#pragma unroll
                    for (int n = 0; n < 2; ++n) acc[a][b][m][n] = (f32x4){0.f, 0.f, 0.f, 0.f};
        cur = nxt; cA = nA; cB = nB; ++ui;
        if constexpr (ALIGN) if (wr == 1) PG8_BAR;
    }
    PG8_WAIT_V(0);
    if constexpr (!ALIGN) if (wr == 0) PG8_BAR;
    PG8_BAR;
#undef PG8_SA
#undef PG8_SB
#undef PG8_STAGE
#undef PG8_LDA
#undef PG8_LDB
#undef PG8_MMA
#undef PG8_WAIT_V
#undef PG8_WAIT_L
#undef PG8_BAR
#undef PG8_SCHED
}

struct EpiBf16 {
    static constexpr bool PERM = true;
    bf16_t* O; int ldc;
    DI void operator()(const f32x4 (&acc)[2][2][4][2], const Unit& u, int wr, int wc, int fr, int fq) const {
        const int row0 = u.pm * BM + wr * 64 + fr, col0 = u.pn * BM + wc * 32 + 8 * fq;
#pragma unroll
        for (int ai = 0; ai < 2; ++ai)
#pragma unroll
            for (int m = 0; m < 4; ++m) { bf16_t* rowp = O + (size_t)(row0 + ai * HALF + m * 16) * ldc + col0;
#pragma unroll
                for (int bj = 0; bj < 2; ++bj) { const f32x4 v0 = acc[ai][bj][m][0], v1 = acc[ai][bj][m][1];
                    u32x4 w; w.x = cvt_pk_bf16(v0[0], v0[1]); w.y = cvt_pk_bf16(v0[2], v0[3]); w.z = cvt_pk_bf16(v1[0], v1[1]); w.w = cvt_pk_bf16(v1[2], v1[3]);
                    *(u32x4*)(rowp + bj * HALF) = w; } }
    }
};
struct EpiWin {
    static constexpr bool PERM = true;
    bf16_t* QKVP; bf16_t* Z; bf16_t* CQKV; float* AB;
    DI void operator()(const f32x4 (&acc)[2][2][4][2], const Unit& u, int wr, int wc, int fr, int fq) const {
        bf16_t* base; int ldc, pn;
        if (u.pn < 6) { base = QKVP; ldc = 1536; pn = u.pn; } else if (u.pn < 8) { base = Z; ldc = 512; pn = u.pn - 6; } else { base = CQKV; ldc = 768; pn = u.pn - 8; }
        const int row0 = u.pm * BM + wr * 64 + fr, col0 = pn * BM + wc * 32 + 8 * fq;
#pragma unroll
        for (int ai = 0; ai < 2; ++ai)
#pragma unroll
            for (int m = 0; m < 4; ++m) { const int row = row0 + ai * HALF + m * 16; bf16_t* rowp = base + (size_t)row * ldc + col0;
#pragma unroll
                for (int bj = 0; bj < 2; ++bj) { const f32x4 v0 = acc[ai][bj][m][0], v1 = acc[ai][bj][m][1];
                    u32x4 w; w.x = cvt_pk_bf16(v0[0], v0[1]); w.y = cvt_pk_bf16(v0[2], v0[3]); w.z = cvt_pk_bf16(v1[0], v1[1]); w.w = cvt_pk_bf16(v1[2], v1[3]);
                    *(u32x4*)(rowp + bj * HALF) = w; }
                if (u.pn == 10 && wc == 1 && fq < 2) { float* ab = AB + (size_t)row * 16 + 8 * fq; *(f32x4*)ab = acc[ai][1][m][0]; *(f32x4*)(ab + 4) = acc[ai][1][m][1]; }
            }
    }
};
struct EpiResid {
    static constexpr bool PERM = false;
    const float* baseL; float* outL; const float* baseC; float* outC; const float* gate;
    DI void operator()(const f32x4 (&acc)[2][2][4][2], const Unit& u, int wr, int wc, int fr, int fq) const {
        const float* bs; float* os; int r, pm;
        if (u.pm < 64) { bs = baseL; os = outL; r = u.pm >> 5; pm = u.pm; } else { bs = baseC; os = outC; r = 2; pm = u.pm - 64; }
        const float* gv = gate + (size_t)r * 6144;
        const int row0 = pm * BM + wr * 64 + fr, col0 = u.pn * BM + wc * 32 + 4 * fq;
        f32x4 gg[2][2];
#pragma unroll
        for (int bj = 0; bj < 2; ++bj)
#pragma unroll
            for (int n = 0; n < 2; ++n) gg[bj][n] = *(const f32x4*)(gv + col0 + bj * HALF + n * 16);
#pragma unroll
        for (int ai = 0; ai < 2; ++ai)
#pragma unroll
            for (int m = 0; m < 4; ++m) { const size_t ro = (size_t)(row0 + ai * HALF + m * 16) * D + col0;
#pragma unroll
                for (int bj = 0; bj < 2; ++bj)
#pragma unroll
                    for (int n = 0; n < 2; ++n) { const f32x4 b = *(const f32x4*)(bs + ro + bj * HALF + n * 16);
                        *(f32x4*)(os + ro + bj * HALF + n * 16) = b + gg[bj][n] * acc[ai][bj][m][n]; } }
    }
};
DI unsigned cvt4_fp8(float a, float b, float c, float d) {
    a = fminf(fmaxf(a, -448.f), 448.f); b = fminf(fmaxf(b, -448.f), 448.f); c = fminf(fmaxf(c, -448.f), 448.f); d = fminf(fmaxf(d, -448.f), 448.f);
    unsigned r = 0; r = __builtin_amdgcn_cvt_pk_fp8_f32(a, b, r, false); r = __builtin_amdgcn_cvt_pk_fp8_f32(c, d, r, true); return r;
}
struct EpiSwigluF8 {
    static constexpr bool PERM = true;
    unsigned char* O; int ldc; float inscale, outscale;
    DI void operator()(const f32x4 (&acc)[2][2][4][2], const Unit& u, int wr, int wc, int fr, int fq) const {
        asm volatile("" : "+v"(fr), "+v"(fq));
        const int row0 = u.pm * BM + wr * 64 + fr, col0 = u.pn * HALF + wc * 32 + 8 * fq;
        const float k1 = -inscale * 1.4426950408889634f, iC = 1.f / (inscale * inscale * outscale);
#pragma unroll
        for (int ai = 0; ai < 2; ++ai)
#pragma unroll
            for (int m = 0; m < 4; ++m) { unsigned char* rowp = O + (size_t)(row0 + ai * HALF + m * 16) * ldc + col0;
                float o[8];
#pragma unroll
                for (int n = 0; n < 2; ++n) { const f32x4 ag = acc[ai][0][m][n], au = acc[ai][1][m][n];
#pragma unroll
                    for (int j = 0; j < 4; ++j) { const float e = __builtin_amdgcn_exp2f(ag[j] * k1);
                        o[4 * n + j] = ag[j] * __builtin_amdgcn_rcpf(__builtin_fmaf(e, iC, iC)) * au[j]; } }
                u32x2 w; w.x = cvt4_fp8(o[0], o[1], o[2], o[3]); w.y = cvt4_fp8(o[4], o[5], o[6], o[7]);
                *(u32x2*)rowp = w; }
    }
};
struct EpiBf16S {
    static constexpr bool PERM = true;
    bf16_t* O; int ldc; float scale;
    DI void operator()(const f32x4 (&acc)[2][2][4][2], const Unit& u, int wr, int wc, int fr, int fq) const {
        asm volatile("" : "+v"(fr), "+v"(fq));
        const int row0 = u.pm * BM + wr * 64 + fr, col0 = u.pn * BM + wc * 32 + 8 * fq;
#pragma unroll
        for (int ai = 0; ai < 2; ++ai)
#pragma unroll
            for (int m = 0; m < 4; ++m) { bf16_t* rowp = O + (size_t)(row0 + ai * HALF + m * 16) * ldc + col0;
#pragma unroll
                for (int bj = 0; bj < 2; ++bj) { const f32x4 v0 = acc[ai][bj][m][0] * scale, v1 = acc[ai][bj][m][1] * scale;
                    u32x4 w; w.x = cvt_pk_bf16(v0[0], v0[1]); w.y = cvt_pk_bf16(v0[2], v0[3]); w.z = cvt_pk_bf16(v1[0], v1[1]); w.w = cvt_pk_bf16(v1[2], v1[3]);
                    *(u32x4*)(rowp + bj * HALF) = w; } }
    }
};
struct EpiMoeTail {
    static constexpr bool PERM = true;
    bf16_t* P; int row0; float scale;
    DI void operator()(const f32x4 (&acc)[2][2][4][2], const Unit& u, int wr, int wc, int fr, int fq) const {
        asm volatile("" : "+v"(fr), "+v"(fq));
        bf16_t* O = P + (size_t)(u.kb / 1792) * (2048 * 1024);
        const int row_ = u.pm * BM - row0 + wr * 64 + fr, col0 = u.pn * BM + wc * 32 + 8 * fq;
#pragma unroll
        for (int ai = 0; ai < 2; ++ai)
#pragma unroll
            for (int m = 0; m < 4; ++m) { bf16_t* rowp = O + (size_t)(row_ + ai * HALF + m * 16) * D + col0;
#pragma unroll
                for (int bj = 0; bj < 2; ++bj) { const f32x4 v0 = acc[ai][bj][m][0] * scale, v1 = acc[ai][bj][m][1] * scale;
                    u32x4 w; w.x = cvt_pk_bf16(v0[0], v0[1]); w.y = cvt_pk_bf16(v0[2], v0[3]); w.z = cvt_pk_bf16(v1[0], v1[1]); w.w = cvt_pk_bf16(v1[2], v1[3]);
                    *(u32x4*)(rowp + bj * HALF) = w; } }
    }
};
struct EpiPartial {
    static constexpr bool PERM = false;
    float* P; float scale;
    DI void operator()(const f32x4 (&acc)[2][2][4][2], const Unit& u, int wr, int wc, int fr, int fq) const {
        float* base = P + (size_t)u.e * (512 * 1024);
        const int row0 = u.pm * BM + wr * 64 + fr, col0 = u.pn * BM + wc * 32 + 4 * fq;
#pragma unroll
        for (int ai = 0; ai < 2; ++ai)
#pragma unroll
            for (int m = 0; m < 4; ++m) { const size_t ro = (size_t)(row0 + ai * HALF + m * 16) * D + col0;
#pragma unroll
                for (int bj = 0; bj < 2; ++bj)
#pragma unroll
                    for (int n = 0; n < 2; ++n) *(f32x4*)(base + ro + bj * HALF + n * 16) = acc[ai][bj][m][n] * scale; }
    }
};
template <bool BASE_F32>
struct EpiResidB {
    static constexpr bool PERM = true;
    const void* base; bf16_t* out; const float* gate; float scale;
    DI void operator()(const f32x4 (&acc)[2][2][4][2], const Unit& u, int wr, int wc, int fr, int fq) const {
        const float* gv = gate + (size_t)(u.pm >> 5) * 6144;
        const int row0 = u.pm * BM + wr * 64 + fr, col0 = u.pn * BM + wc * 32 + 8 * fq;
        f32x4 gg[2][2];
#pragma unroll
        for (int bj = 0; bj < 2; ++bj)
#pragma unroll
            for (int n = 0; n < 2; ++n) gg[bj][n] = *(const f32x4*)(gv + col0 + bj * HALF + 4 * n) * scale;
        constexpr int MB = 4;
#pragma unroll
        for (int ai = 0; ai < 2; ++ai)
#pragma unroll
            for (int mb = 0; mb < 4; mb += MB) {
                f32x4 b0[MB][2], b1[MB][2];
#pragma unroll
                for (int mm = 0; mm < MB; ++mm) { const size_t ro = (size_t)(row0 + ai * HALF + (mb + mm) * 16) * D + col0;
#pragma unroll
                    for (int bj = 0; bj < 2; ++bj) {
                        if constexpr (BASE_F32) { b0[mm][bj] = __builtin_nontemporal_load((const f32x4*)((const float*)base + ro + bj * HALF)); b1[mm][bj] = __builtin_nontemporal_load((const f32x4*)((const float*)base + ro + bj * HALF + 4)); }
                        else { const u32x4 rb = *(const u32x4*)((const bf16_t*)base + ro + bj * HALF);
                            b0[mm][bj] = (f32x4){bflo(rb.x), bfhi(rb.x), bflo(rb.y), bfhi(rb.y)}; b1[mm][bj] = (f32x4){bflo(rb.z), bfhi(rb.z), bflo(rb.w), bfhi(rb.w)}; } } }
#pragma unroll
                for (int mm = 0; mm < MB; ++mm) { const int m = mb + mm; const size_t ro = (size_t)(row0 + ai * HALF + m * 16) * D + col0;
#pragma unroll
                    for (int bj = 0; bj < 2; ++bj) {
                        const f32x4 v0 = b0[mm][bj] + gg[bj][0] * acc[ai][bj][m][0], v1 = b1[mm][bj] + gg[bj][1] * acc[ai][bj][m][1];
                        u32x4 w; w.x = cvt_pk_bf16(v0[0], v0[1]); w.y = cvt_pk_bf16(v0[2], v0[3]); w.z = cvt_pk_bf16(v1[0], v1[1]); w.w = cvt_pk_bf16(v1[2], v1[3]);
                        *(u32x4*)(out + ro + bj * HALF) = w; } }
            }
    }
};
struct EpiSwiglu {
    static constexpr bool PERM = true;
    bf16_t* O; int ldc;
    DI void operator()(const f32x4 (&acc)[2][2][4][2], const Unit& u, int wr, int wc, int fr, int fq) const {
        const int row0 = u.pm * BM + wr * 64 + fr, col0 = u.pn * HALF + wc * 32 + 8 * fq;
#pragma unroll
        for (int ai = 0; ai < 2; ++ai)
#pragma unroll
            for (int m = 0; m < 4; ++m) { bf16_t* rowp = O + (size_t)(row0 + ai * HALF + m * 16) * ldc + col0;
                float o[8];
#pragma unroll
                for (int n = 0; n < 2; ++n) { const f32x4 gt = acc[ai][0][m][n], up = acc[ai][1][m][n];
#pragma unroll
                    for (int j = 0; j < 4; ++j) { const float e = __builtin_amdgcn_exp2f(-gt[j]);
                        o[4 * n + j] = gt[j] * up[j] * __builtin_amdgcn_rcpf(__builtin_fmaf(e, 1.4426950408889634f, 1.4426950408889634f)); } }
                u32x4 w; w.x = cvt_pk_bf16(o[0], o[1]); w.y = cvt_pk_bf16(o[2], o[3]); w.z = cvt_pk_bf16(o[4], o[5]); w.w = cvt_pk_bf16(o[6], o[7]);
                *(u32x4*)rowp = w; }
    }
};
struct EpiSwigluQ8 {
    static constexpr bool PERM = true;
    unsigned char* O; int ldc;
    DI void operator()(const f32x4 (&acc)[2][2][4][2], const Unit& u, int wr, int wc, int fr, int fq) const {
        const int row0 = u.pm * BM + wr * 64 + fr, col0 = u.pn * HALF + wc * 32 + 8 * fq;
#pragma unroll
        for (int ai = 0; ai < 2; ++ai)
#pragma unroll
            for (int m = 0; m < 4; ++m) { unsigned char* rowp = O + (size_t)(row0 + ai * HALF + m * 16) * ldc + col0;
                float o[8];
#pragma unroll
                for (int n = 0; n < 2; ++n) { const f32x4 gt = acc[ai][0][m][n], up = acc[ai][1][m][n];
#pragma unroll
                    for (int j = 0; j < 4; ++j) { const float e = __builtin_amdgcn_exp2f(-gt[j]);
                        o[4 * n + j] = gt[j] * up[j] * __builtin_amdgcn_rcpf(__builtin_fmaf(e, 1.4426950408889634f / 8.f, 1.4426950408889634f / 8.f)); } }
                u32x2 w; w.x = cvt4_fp8(o[0], o[1], o[2], o[3]); w.y = cvt4_fp8(o[4], o[5], o[6], o[7]);
                *(u32x2*)rowp = w; }
    }
};
}

typedef __bf16 bf2_t __attribute__((ext_vector_type(2)));
typedef float f2_t __attribute__((ext_vector_type(2)));
DI unsigned cvtpk(float lo, float hi) { f2_t v = {lo, hi}; return __builtin_bit_cast(unsigned, __builtin_convertvector(v, bf2_t)); }
#define MFMA32(a, b, c) __builtin_amdgcn_mfma_f32_32x32x16_bf16((a), (b), (c), 0, 0, 0)
DI int crow(int reg, int h) { return (reg & 3) + 8 * (reg >> 2) + 4 * h; }

struct Frame {
    LAS unsigned char* lds;
    volatile LAS unsigned* MISC;
    unsigned* ctl;
    unsigned char* ws;
    int tid, lane, wave, G, bid;
    const float* const* in;
    float* out;
};

constexpr int VROW = 136;
constexpr float LOG2E = 1.4426950408889634f;
constexpr float NEG_BIG = -1.0e30f;
constexpr float ATT_THR = 8.f;

template <int NS, int KROWB>
DI void attn_scores(const LAS unsigned char* Ks, int r, int h, const bf16x8 (&qf)[NS], f32x16 (&x)[2], const f32x16& nin) {
    bf16x8 kf[2][NS];
#pragma unroll
    for (int kb = 0; kb < 2; ++kb)
#pragma unroll
        for (int s = 0; s < NS; ++s) kf[kb][s] = *(const LAS bf16x8*)(Ks + (32 * kb + r) * KROWB + (16 * s + 8 * h) * 2);
    __builtin_amdgcn_sched_barrier(0);
#pragma unroll
    for (int kb = 0; kb < 2; ++kb) {
        x[kb] = MFMA32(kf[kb][0], qf[0], nin);
#pragma unroll
        for (int s = 1; s < NS; ++s) x[kb] = MFMA32(kf[kb][s], qf[s], x[kb]);
    }
}
DI float attn_mref(float m) { return m < -1.0e29f ? 0.f : m; }
DI void attn_softmax_pv(f32x16 (&x)[2], f32x16& nin, float& m, f32x16& ls, f32x16 (&o)[2], const LAS unsigned char* Vs, int r, int h) {
    const float mr = -nin[0];
    s16x4 vlo[2][2][2], vhi[2][2][2];
#pragma unroll
    for (int kb = 0; kb < 2; ++kb)
#pragma unroll
        for (int s2 = 0; s2 < 2; ++s2)
#pragma unroll
            for (int db = 0; db < 2; ++db) {
                const LAS unsigned char* vp = Vs + (32 * db + r) * VROW + (32 * kb + 16 * s2 + 4 * h) * 2;
                vlo[kb][s2][db] = *(const LAS s16x4*)vp; vhi[kb][s2][db] = *(const LAS s16x4*)(vp + 16);
            }
    __builtin_amdgcn_sched_barrier(0);
    float mt = fmaxf(fmaxf(x[0][0], x[0][1]), x[0][2]);
#pragma unroll
    for (int i = 3; i < 15; i += 2) mt = fmaxf(fmaxf(mt, x[0][i]), x[0][i + 1]);
    mt = fmaxf(mt, x[0][15]);
#pragma unroll
    for (int i = 0; i < 16; i += 2) mt = fmaxf(fmaxf(mt, x[1][i]), x[1][i + 1]);
    { const auto sw_ = __builtin_amdgcn_permlane32_swap(__builtin_bit_cast(unsigned, mt), __builtin_bit_cast(unsigned, mt), false, false);
      mt = fmaxf(__builtin_bit_cast(float, sw_[0]), __builtin_bit_cast(float, sw_[1])); }
    const float mnew = fmaxf(m, mr + mt);
    const float shift = mnew - mr;
    if (__any(shift > ATT_THR || m < -1.0e29f)) {
        const float alpha = __builtin_amdgcn_exp2f(m - mnew);
#pragma unroll
        for (int i = 0; i < 16; ++i) ls[i] *= alpha;
#pragma unroll
        for (int db = 0; db < 2; ++db)
#pragma unroll
            for (int i = 0; i < 16; ++i) o[db][i] *= alpha;
#pragma unroll
        for (int kb = 0; kb < 2; ++kb)
#pragma unroll
            for (int i = 0; i < 16; ++i) x[kb][i] -= shift;
        m = mnew;
        const float nv = -attn_mref(mnew);
#pragma unroll
        for (int i = 0; i < 16; ++i) asm volatile("v_mov_b32 %0, %1" : "+v"(nin[i]) : "v"(nv));
    }
#pragma unroll
    for (int kb = 0; kb < 2; ++kb)
#pragma unroll
        for (int i = 0; i < 16; ++i) x[kb][i] = __builtin_amdgcn_exp2f(x[kb][i]);
    const bf16x8 ones = {(short)0x3F80, (short)0x3F80, (short)0x3F80, (short)0x3F80, (short)0x3F80, (short)0x3F80, (short)0x3F80, (short)0x3F80};
#pragma unroll
    for (int kb = 0; kb < 2; ++kb)
#pragma unroll
        for (int s2 = 0; s2 < 2; ++s2) {
            u32x4 pp;
            pp.x = cvtpk(x[kb][8 * s2 + 0], x[kb][8 * s2 + 1]); pp.y = cvtpk(x[kb][8 * s2 + 2], x[kb][8 * s2 + 3]);
            pp.z = cvtpk(x[kb][8 * s2 + 4], x[kb][8 * s2 + 5]); pp.w = cvtpk(x[kb][8 * s2 + 6], x[kb][8 * s2 + 7]);
            const bf16x8 pf = __builtin_bit_cast(bf16x8, pp);
#pragma unroll
            for (int db = 0; db < 2; ++db) {
                const bf16x8 vf = __builtin_shufflevector(vlo[kb][s2][db], vhi[kb][s2][db], 0, 1, 2, 3, 4, 5, 6, 7);
                o[db] = MFMA32(vf, pf, o[db]);
            }
            ls = MFMA32(ones, pf, ls);
        }
}
DI void attn_store(const f32x16 (&o)[2], float l, bf16_t* orow, int h) {
    const float inv = 1.f / l;
#pragma unroll
    for (int db = 0; db < 2; ++db)
#pragma unroll
        for (int g = 0; g < 4; ++g) {
            u32x2 w; w.x = cvtpk(o[db][4 * g] * inv, o[db][4 * g + 1] * inv); w.y = cvtpk(o[db][4 * g + 2] * inv, o[db][4 * g + 3] * inv);
            *(u32x2*)(orow + 32 * db + 8 * g + 4 * h) = w;
        }
}

DI void attn_store_f8(const f32x16 (&o)[2], float l, unsigned char* orow, int h) {
    const float inv = 8.f / l;
#pragma unroll
    for (int db = 0; db < 2; ++db)
#pragma unroll
        for (int g = 0; g < 4; ++g)
            *(unsigned*)(orow + 32 * db + 8 * g + 4 * h) = pg8::cvt4_fp8(o[db][4 * g] * inv, o[db][4 * g + 1] * inv, o[db][4 * g + 2] * inv, o[db][4 * g + 3] * inv);
}
constexpr int MLA_KROWB = 208, MLA_TILE = 64 * MLA_KROWB + 64 * VROW;
DI void mla_unit(Frame& F, int b, int head, int qb) {
    const bf16_t* MLAQ = (const bf16_t*)(F.ws + WS_MLAQ); const bf16_t* KN = (const bf16_t*)(F.ws + WS_KN);
    const bf16_t* KR = (const bf16_t*)(F.ws + WS_KR); const bf16_t* VT = (const bf16_t*)(F.ws + WS_VT);
    const float* ROPE = (const float*)(F.ws + WS_ROPE);
    bf16_t* MIX = (bf16_t*)(F.ws + WS_H);
    int tid_ = F.tid, lane_ = F.lane;
    asm volatile("" : "+v"(tid_), "+v"(lane_));
    const int r = lane_ & 31, h = lane_ >> 5;
    const int g = F.wave >> 2, wq = F.wave & 3;
    const bool lat = qb >= 0;
    const int t = lat ? qb * 128 + wq * 32 + r : 0;
    const int qrow = lat ? b * SEQ + t : ML + b * LC + (-1 - qb) * 128 + wq * 32 + r;
    const float qs = 0.10206207261596577f * LOG2E;
    bf16x8 qf[6];
    {
        const bf16_t* qp = MLAQ + (size_t)qrow * 768 + head * 96;
#pragma unroll
        for (int s = 0; s < 6; ++s) {
            const u32x4 raw = *(const u32x4*)(qp + 16 * s + 8 * h);
            float v[8];
            v[0] = bflo(raw.x); v[1] = bfhi(raw.x); v[2] = bflo(raw.y); v[3] = bfhi(raw.y); v[4] = bflo(raw.z); v[5] = bfhi(raw.z); v[6] = bflo(raw.w); v[7] = bfhi(raw.w);
            if (s >= 4 && lat) {
                const int i0 = 8 * (s - 4) + 4 * h;
                const f32x4 cs = *(const f32x4*)(ROPE + (size_t)t * 16 + i0), sn = *(const f32x4*)(ROPE + (size_t)SEQ * 16 + (size_t)t * 16 + i0);
#pragma unroll
                for (int p = 0; p < 4; ++p) { const float a = v[2 * p], bb = v[2 * p + 1]; v[2 * p] = a * cs[p] - bb * sn[p]; v[2 * p + 1] = bb * cs[p] + a * sn[p]; }
            }
            u32x4 pk; pk.x = cvtpk(v[0] * qs, v[1] * qs); pk.y = cvtpk(v[2] * qs, v[3] * qs); pk.z = cvtpk(v[4] * qs, v[5] * qs); pk.w = cvtpk(v[6] * qs, v[7] * qs);
            qf[s] = __builtin_bit_cast(bf16x8, pk);
        }
    }
    float m = NEG_BIG;
    f32x16 o[2], ls, nin;
#pragma unroll
    for (int i = 0; i < 16; ++i) { ls[i] = 0.f; nin[i] = -0.f; }
#pragma unroll
    for (int db = 0; db < 2; ++db)
#pragma unroll
        for (int i = 0; i < 16; ++i) o[db][i] = 0.f;
    const int npair = lat ? 66 : 2;
    unsigned koff[3], krb[3], kdst[3], voff[2], vdst[2];
#pragma unroll
    for (int j = 0; j < 3; ++j) { const int id = tid_ + 512 * j, sl = id / 768, rem = id - sl * 768, row = rem / 12, ch = rem - row * 12;
        const int rl = b * SEQ + 64 * sl + row;
        if (ch < 8) { koff[j] = (unsigned)(WS_KN + ((size_t)rl * 512 + head * 64 + ch * 8) * 2); krb[j] = 1024u; }
        else { koff[j] = (unsigned)(WS_KR + ((size_t)rl * 32 + (ch - 8) * 8) * 2); krb[j] = 64u; }
        kdst[j] = sl * MLA_TILE + row * MLA_KROWB + ch * 16; }
#pragma unroll
    for (int j = 0; j < 2; ++j) { const int id = tid_ + 512 * j, sl = id >> 9, dvr = (id & 511) >> 3, ch = id & 7;
        voff[j] = (unsigned)(WS_VT + ((size_t)(head * 64 + dvr) * MT + b * SEQ + 64 * sl + ch * 8) * 2);
        vdst[j] = sl * MLA_TILE + 64 * MLA_KROWB + dvr * VROW + ch * 16; }
    const int ctx0 = ML + b * LC - b * SEQ;
    u32x4 rk[3], rv[2];
#define MLA_LOAD(ip) do { const unsigned kr_ = (unsigned)((ip) < 2 ? ctx0 + 128 * (ip) : 128 * ((ip) - 2)); \
        _Pragma("unroll") for (int j = 0; j < 3; ++j) rk[j] = *(const u32x4*)(F.ws + (koff[j] + kr_ * krb[j])); \
        _Pragma("unroll") for (int j = 0; j < 2; ++j) rv[j] = *(const u32x4*)(F.ws + (voff[j] + kr_ * 2u)); } while (0)
#define MLA_STORE(st) do { LAS unsigned char* sb = F.lds + (st) * 2 * MLA_TILE; \
        _Pragma("unroll") for (int j = 0; j < 3; ++j) *(LAS u32x4*)(sb + kdst[j]) = rk[j]; \
        _Pragma("unroll") for (int j = 0; j < 2; ++j) { LAS unsigned char* d_ = sb + vdst[j]; *(LAS u32x2*)d_ = (u32x2){rv[j].x, rv[j].y}; *(LAS u32x2*)(d_ + 8) = (u32x2){rv[j].z, rv[j].w}; } } while (0)
    __syncthreads();
    MLA_LOAD(0); MLA_STORE(0);
    if (npair > 1) MLA_LOAD(1);
    __syncthreads();
    for (int ip = 0; ip < npair; ++ip) {
        if (ip + 1 < npair) MLA_STORE((ip + 1) & 1);
        if (ip + 2 < npair) MLA_LOAD(ip + 2);
        const LAS unsigned char* Ks = F.lds + ((ip & 1) * 2 + g) * MLA_TILE;
        f32x16 x[2];
        attn_scores<6, MLA_KROWB>(Ks, r, h, qf, x, nin);
        attn_softmax_pv(x, nin, m, ls, o, Ks + 64 * MLA_KROWB, r, h);
        __syncthreads();
    }
#undef MLA_LOAD
#undef MLA_STORE
    LAS float* cmb = (LAS float*)F.lds;
    if (g == 1) {
        LAS float* cw = cmb + wq * 34 * 64 + F.lane;
#pragma unroll
        for (int db = 0; db < 2; ++db)
#pragma unroll
            for (int i = 0; i < 16; ++i) cw[(db * 16 + i) * 64] = o[db][i];
        cw[32 * 64] = attn_mref(m); cw[33 * 64] = ls[0];
    }
    __syncthreads();
    if (g == 0) {
        const LAS float* cw = cmb + wq * 34 * 64 + F.lane;
        const float m1 = cw[32 * 64], l1 = cw[33 * 64];
        m = attn_mref(m);
        const float mt = fmaxf(m, m1);
        const float a0 = __builtin_amdgcn_exp2f(m - mt), a1 = __builtin_amdgcn_exp2f(m1 - mt);
        const float l = ls[0] * a0 + l1 * a1;
#pragma unroll
        for (int db = 0; db < 2; ++db)
#pragma unroll
            for (int i = 0; i < 16; ++i) o[db][i] = o[db][i] * a0 + cw[(db * 16 + i) * 64] * a1;
        attn_store(o, l, MIX + (size_t)qrow * D + 512 + head * 64, h);
    }
}

constexpr int NA_KROWB = 144, NA_TILE = 64 * NA_KROWB + 64 * VROW;
DI void na_unit(Frame& F, int b, int head, int rg) {
    LAS float* rpbs = (LAS float*)(F.lds + 4 * NA_TILE);
    const bf16_t* QK1 = (const bf16_t*)(F.ws + WS_QK1); const bf16_t* VT1 = (const bf16_t*)(F.ws + WS_VT1);
    bf16_t* O1 = (bf16_t*)(F.ws + WS_O1);
    const float* rpb = F.in[21] + head * 465;
    const int r = F.lane & 31, h = F.lane >> 5;
    const int rq = 4 * rg + (F.wave >> 1), cq = 32 * (F.wave & 1) + r;
    const int qrow = b * SEQ + rq * 64 + cq;
    const int r0q = min(max(rq - 4, 0), 120);
    const int c0 = min(max(cq - 8, 0), 48);
    const float qs = 0.125f * LOG2E;
    __syncthreads();
    for (int i = F.tid; i < 465; i += 512) rpbs[i] = rpb[i] * LOG2E;
    bf16x8 qf[4];
    {
        const bf16_t* qp = QK1 + (size_t)qrow * 2048 + head * 64;
#pragma unroll
        for (int s = 0; s < 4; ++s) {
            const u32x4 raw = *(const u32x4*)(qp + 16 * s + 8 * h);
            u32x4 pk; pk.x = cvtpk(bflo(raw.x) * qs, bfhi(raw.x) * qs); pk.y = cvtpk(bflo(raw.y) * qs, bfhi(raw.y) * qs);
            pk.z = cvtpk(bflo(raw.z) * qs, bfhi(raw.z) * qs); pk.w = cvtpk(bflo(raw.w) * qs, bfhi(raw.w) * qs);
            qf[s] = __builtin_bit_cast(bf16x8, pk);
        }
    }
    float m = NEG_BIG;
    f32x16 o[2], ls, nin;
#pragma unroll
    for (int i = 0; i < 16; ++i) { ls[i] = 0.f; nin[i] = -0.f; }
#pragma unroll
    for (int db = 0; db < 2; ++db)
#pragma unroll
        for (int i = 0; i < 16; ++i) o[db][i] = 0.f;
    const int kr_lo = min(max(4 * rg - 4, 0), 120), kr_hi = min(max(4 * rg - 1, 0), 120) + 7;
    const int nnb = kr_hi - kr_lo + 1, ntile = nnb + 4, npair = (ntile + 1) >> 1;
    const int krr = F.tid >> 3, kch = F.tid & 7;
    u32x4 rk[2], rv[2];
#define NA_TILE_OF(p) ((nnb == 11 && (p) < 11) ? ((p) < 6 ? (((p) & 1) ? 8 + ((p) >> 1) : ((p) >> 1)) : (p) - 3) : (p))
#define NA_KBASE(kt) (((kt) < nnb) ? b * SEQ + (kr_lo + (kt)) * 64 : ML + b * LC + 64 * ((kt) - nnb))
#define NA_LOAD(ip) do { _Pragma("unroll") for (int j = 0; j < 2; ++j) { const int pp_ = min(2 * (ip) + j, ntile - 1); const int kt_ = NA_TILE_OF(pp_); const int kbase = NA_KBASE(kt_); \
        rk[j] = *(const u32x4*)(QK1 + (size_t)(kbase + krr) * 2048 + 1024 + head * 64 + kch * 8); \
        rv[j] = *(const u32x4*)(VT1 + (size_t)(head * 64 + krr) * MT + kbase + kch * 8); } } while (0)
#define NA_STORE(st) do { _Pragma("unroll") for (int j = 0; j < 2; ++j) { LAS unsigned char* tb = F.lds + ((st) * 2 + j) * NA_TILE; \
        *(LAS u32x4*)(tb + krr * NA_KROWB + kch * 16) = rk[j]; \
        LAS unsigned char* d_ = tb + 64 * NA_KROWB + krr * VROW + kch * 16; *(LAS u32x2*)d_ = (u32x2){rv[j].x, rv[j].y}; *(LAS u32x2*)(d_ + 8) = (u32x2){rv[j].z, rv[j].w}; } } while (0)
    NA_LOAD(0); NA_STORE(0);
    if (npair > 1) NA_LOAD(1);
    __syncthreads();
    for (int ip = 0; ip < npair; ++ip) {
        if (ip + 1 < npair) NA_STORE((ip + 1) & 1);
        if (ip + 2 < npair) NA_LOAD(ip + 2);
#pragma unroll
        for (int sl = 0; sl < 2; ++sl) {
            if (2 * ip + sl >= ntile) continue;
            const int kt = NA_TILE_OF(2 * ip + sl);
            const bool nb = kt < nnb;
            const int krow = kr_lo + kt;
            if (nb && (krow < r0q || krow > r0q + 7)) continue;
            const LAS unsigned char* Ks = F.lds + ((ip & 1) * 2 + sl) * NA_TILE;
            f32x16 x[2];
            attn_scores<4, NA_KROWB>(Ks, r, h, qf, x, nin);
            if (nb) {
                const LAS float* bp = rpbs + ((krow - rq + 7) * 31 - cq + 15 + 4 * h);
                float bias[2][16];
#pragma unroll
                for (int kb = 0; kb < 2; ++kb)
#pragma unroll
                    for (int i = 0; i < 16; ++i) bias[kb][i] = bp[32 * kb + (i & 3) + 8 * (i >> 2)];
                asm volatile("" : "+v"(bias[0][0]));
#pragma unroll
                for (int kb = 0; kb < 2; ++kb)
#pragma unroll
                    for (int i = 0; i < 16; ++i) {
                        const int kc = 32 * kb + crow(i, h);
                        const bool valid = (unsigned)(kc - c0) <= 15u;
                        x[kb][i] = valid ? x[kb][i] + bias[kb][i] : NEG_BIG;
                    }
            }
            attn_softmax_pv(x, nin, m, ls, o, Ks + 64 * NA_KROWB, r, h);
        }
        __syncthreads();
    }
#undef NA_LOAD
#undef NA_STORE
#undef NA_KBASE
#undef NA_TILE_OF
    attn_store_f8(o, ls[0], (unsigned char*)O1 + (size_t)qrow * D + head * 64, h);
}

DI void norm_mod_row(const f32x4 (&v)[4], const float* g, const float* sc, const float* sh, bf16_t* orow, int lane) {
    float s = 0.f;
#pragma unroll
    for (int j = 0; j < 4; ++j) s += (v[j].x * v[j].x + v[j].y * v[j].y) + (v[j].z * v[j].z + v[j].w * v[j].w);
    const float rs = __builtin_amdgcn_rsqf(wave_sum(s) * (1.f / D) + EPS);
    u32x2* o8 = (u32x2*)orow + lane;
    f32x4 gg_[4], cc_[4], hh_[4];
#pragma unroll
    for (int j = 0; j < 4; ++j) { gg_[j] = ((const f32x4*)g)[lane + 64 * j]; cc_[j] = ((const f32x4*)sc)[lane + 64 * j]; hh_[j] = ((const f32x4*)sh)[lane + 64 * j]; }
#pragma unroll
    for (int j = 0; j < 4; ++j) {
        const f32x4 gg = gg_[j], cc = cc_[j], hh = hh_[j];
        f32x4 y;
#pragma unroll
        for (int k = 0; k < 4; ++k) y[k] = v[j][k] * rs * gg[k] * (1.f + cc[k]) + hh[k];
        u32x2 w; w.x = cvtpk(y[0], y[1]); w.y = cvtpk(y[2], y[3]); o8[64 * j] = w;
    }
}
template <bool XL16 = false, bool F8 = false>
DI void phase_norm_mod(Frame& F, const float* xl, const float* xc, int nrows, int layer, int sub, bf16_t* H, const float* part, int ks, const float* cgate, float* xcw) {
    const float* MOD = (const float*)(F.ws + WS_MOD) + (size_t)layer * 3 * 6144;
    const float* g = F.in[6] + (size_t)(layer * 2 + sub) * D;
    const int gw = F.bid * 8 + F.wave, NGW = F.G * 8;
    if (nrows > ML) {
        for (int cr = NGW - 1 - gw; cr < MC; cr += NGW) {
            const float* mr = MOD + (size_t)2 * 6144 + (sub ? 3 * D : 0);
            const f32x4* xr = (const f32x4*)(xc + (size_t)cr * D) + F.lane;
            f32x4 v[4]; float s = 0.f;
            if (ks > 0) {
                f32x4 a[4];
#pragma unroll
                for (int j = 0; j < 4; ++j) a[j] = (f32x4){0.f, 0.f, 0.f, 0.f};
                const f32x4* pp = (const f32x4*)(part + (size_t)cr * D) + F.lane;
#pragma unroll 1
                for (int e = 0; e < ks; e += 4) {
                    f32x4 t[4][4]; float wgt[4];
#pragma unroll
                    for (int i = 0; i < 4; ++i) { const int ec = min(e + i, ks - 1); wgt[i] = (e + i < ks) ? 1.f : 0.f;
#pragma unroll
                        for (int j = 0; j < 4; ++j) t[i][j] = pp[(size_t)ec * ((512 * 1024) / 4) + 64 * j]; }
#pragma unroll
                    for (int i = 0; i < 4; ++i)
#pragma unroll
                        for (int j = 0; j < 4; ++j) a[j] += wgt[i] * t[i][j];
                }
#pragma unroll
                for (int j = 0; j < 4; ++j) v[j] = xr[64 * j] + ((const f32x4*)cgate)[F.lane + 64 * j] * a[j];
                if (xcw) {
#pragma unroll
                    for (int j = 0; j < 4; ++j) ((f32x4*)(xcw + (size_t)cr * D))[F.lane + 64 * j] = v[j]; }
            } else {
#pragma unroll
                for (int j = 0; j < 4; ++j) v[j] = xr[64 * j];
            }
#pragma unroll
            for (int j = 0; j < 4; ++j) s += (v[j].x * v[j].x + v[j].y * v[j].y) + (v[j].z * v[j].z + v[j].w * v[j].w);
            const float rs = __builtin_amdgcn_rsqf(wave_sum(s) * (1.f / D) + EPS);
            u32x2* o8 = (u32x2*)(H + (size_t)(ML + cr) * D) + F.lane; unsigned* o4 = (unsigned*)((unsigned char*)H + (size_t)(ML + cr) * D) + F.lane;
            f32x4 gg_[4], cc_[4], hh_[4];
#pragma unroll
            for (int j = 0; j < 4; ++j) { gg_[j] = ((const f32x4*)g)[F.lane + 64 * j]; cc_[j] = ((const f32x4*)(mr + D))[F.lane + 64 * j]; hh_[j] = ((const f32x4*)mr)[F.lane + 64 * j]; }
#pragma unroll
            for (int j = 0; j < 4; ++j) {
                const f32x4 gg = gg_[j], cc = cc_[j], hh = hh_[j];
                f32x4 y;
#pragma unroll
                for (int k = 0; k < 4; ++k) y[k] = v[j][k] * rs * gg[k] * (1.f + cc[k]) + hh[k];
                if constexpr (F8) o4[64 * j] = pg8::cvt4_fp8(y[0] * 8.f, y[1] * 8.f, y[2] * 8.f, y[3] * 8.f);
                else { u32x2 w; w.x = cvtpk(y[0], y[1]); w.y = cvtpk(y[2], y[3]); o8[64 * j] = w; }
            }
        }
    }
    f32x4 nv[4];
    if constexpr (!XL16) { if (gw < ML) { const f32x4* xr = (const f32x4*)(xl + (size_t)gw * D) + F.lane;
#pragma unroll
        for (int j = 0; j < 4; ++j) nv[j] = __builtin_nontemporal_load(xr + 64 * j); } }
    u32x2 nx[4];
    if constexpr (XL16) { if (gw < ML) { const u32x2* xr = (const u32x2*)((const bf16_t*)xl + (size_t)gw * D) + F.lane;
#pragma unroll
        for (int j = 0; j < 4; ++j) nx[j] = xr[64 * j]; } }
    for (int row = gw; row < ML; row += NGW) {
        const int r = row < SEQ ? 0 : 1;
        const float* mr = MOD + (size_t)r * 6144 + (sub ? 3 * D : 0);
        if constexpr (!XL16) {
            f32x4 cv[4];
#pragma unroll
            for (int j = 0; j < 4; ++j) cv[j] = nv[j];
            if (row + NGW < ML) { const f32x4* xn = (const f32x4*)(xl + (size_t)(row + NGW) * D) + F.lane;
#pragma unroll
                for (int j = 0; j < 4; ++j) nv[j] = __builtin_nontemporal_load(xn + 64 * j); }
            norm_mod_row(cv, g, mr + D, mr, H + (size_t)row * D, F.lane);
        } else {
            u32x2 cx[4];
#pragma unroll
            for (int j = 0; j < 4; ++j) cx[j] = nx[j];
            if (row + NGW < ML) { const u32x2* xn = (const u32x2*)((const bf16_t*)xl + (size_t)(row + NGW) * D) + F.lane;
#pragma unroll
                for (int j = 0; j < 4; ++j) nx[j] = xn[64 * j]; }
            f32x4 v[4]; float ssq = 0.f;
#pragma unroll
            for (int j = 0; j < 4; ++j) { const u32x2 a = cx[j]; v[j] = (f32x4){bflo(a.x), bfhi(a.x), bflo(a.y), bfhi(a.y)}; ssq += (v[j].x * v[j].x + v[j].y * v[j].y) + (v[j].z * v[j].z + v[j].w * v[j].w); }
            const float rs = __builtin_amdgcn_rsqf(wave_sum(ssq) * (1.f / D) + EPS);
            u32x2* o8 = (u32x2*)(H + (size_t)row * D) + F.lane; unsigned* o4 = (unsigned*)((unsigned char*)H + (size_t)row * D) + F.lane;
            f32x4 gg_[4], cc_[4], hh_[4];
#pragma unroll
            for (int j = 0; j < 4; ++j) { gg_[j] = ((const f32x4*)g)[F.lane + 64 * j]; cc_[j] = ((const f32x4*)(mr + D))[F.lane + 64 * j]; hh_[j] = ((const f32x4*)mr)[F.lane + 64 * j]; }
#pragma unroll
            for (int j = 0; j < 4; ++j) {
                const f32x4 gg = gg_[j], cc = cc_[j], hh = hh_[j];
                f32x4 y;
#pragma unroll
                for (int k = 0; k < 4; ++k) y[k] = v[j][k] * rs * gg[k] * (1.f + cc[k]) + hh[k];
                if constexpr (F8) o4[64 * j] = pg8::cvt4_fp8(y[0] * 8.f, y[1] * 8.f, y[2] * 8.f, y[3] * 8.f);
                else { u32x2 w; w.x = cvtpk(y[0], y[1]); w.y = cvtpk(y[2], y[3]); o8[64 * j] = w; }
            }
        }
    }
}

DI void phase_prep(Frame& F) {
    const bf16_t* QKVP = (const bf16_t*)(F.ws + WS_QKVP); bf16_t* QKVC = (bf16_t*)(F.ws + WS_QKVC); bf16_t* CQKV = (bf16_t*)(F.ws + WS_CQKV);
    const float* AB = (const float*)(F.ws + WS_AB); float* GB = (float*)(F.ws + WS_GB); const float* ROPE = (const float*)(F.ws + WS_ROPE);
    LAS float* cw = (LAS float*)F.lds;
    __syncthreads();
    for (int i = F.tid; i < 5 * 1536; i += 512) cw[i] = F.in[8][i];
    __syncthreads();
    const float* a_log = F.in[9]; const float* dt_bias = F.in[10]; const float* qg = F.in[12]; const float* kvg = F.in[14];
    const int lane = F.lane;
    const int gw = F.bid * 8 + F.wave, NGW = F.G * 8;
    const float dtb_ = dt_bias[lane & 7], nal_ = -__expf(a_log[lane & 7]);
    float qg8[8], kg8[8];
    { const f32x4 a0 = *(const f32x4*)(qg + min(lane, 47) * 8), a1 = *(const f32x4*)(qg + min(lane, 47) * 8 + 4), b0 = *(const f32x4*)(kvg + (lane & 31) * 8), b1 = *(const f32x4*)(kvg + (lane & 31) * 8 + 4);
#pragma unroll
      for (int j = 0; j < 4; ++j) { qg8[j] = a0[j]; qg8[4 + j] = a1[j]; kg8[j] = b0[j]; kg8[4 + j] = b1[j]; } }
    for (int row = gw; row < MT; row += NGW) {
        int t, len, rbase;
        if (row < ML) { t = row & (SEQ - 1); len = SEQ; rbase = row - t; } else { t = (row - ML) & (LC - 1); len = LC; rbase = row - t; }
        u32x4 rawc[3][5];
#pragma unroll
        for (int part = 0; part < 3; ++part)
#pragma unroll
            for (int k = 0; k < 5; ++k) { const int tc = min(max(t + k - 2, 0), len - 1);
                rawc[part][k] = *(const u32x4*)(QKVP + (size_t)(rbase + tc) * 1536 + part * 512 + lane * 8); }
        const bf16_t* crl = CQKV + (size_t)row * 768;
        const u32x4 rawq = *(const u32x4*)(crl + min(lane, 47) * 8), rawk = *(const u32x4*)(crl + 384 + (lane & 31) * 8), rawr = *(const u32x4*)(crl + 640 + (lane & 3) * 8);
        const float ab_a = AB[(size_t)row * 16 + (lane & 7)], ab_b = AB[(size_t)row * 16 + 8 + (lane & 7)];
        const int tr_ = row < ML ? t : 0;
        const f32x4 rcs = *(const f32x4*)(ROPE + (size_t)tr_ * 16 + 4 * (lane & 3)), rsn = *(const f32x4*)(ROPE + (size_t)SEQ * 16 + (size_t)tr_ * 16 + 4 * (lane & 3));
#pragma unroll
        for (int part = 0; part < 3; ++part) {
            const int c0 = part * 512 + lane * 8;
            float acc[8];
#pragma unroll
            for (int j = 0; j < 8; ++j) acc[j] = 0.f;
#pragma unroll
            for (int k = 0; k < 5; ++k) {
                const int tt = t + k - 2;
                if (tt >= 0 && tt < len) {
                    const u32x4 raw = rawc[part][k];
                    const f32x4 w0 = *(const LAS f32x4*)(cw + k * 1536 + c0), w1 = *(const LAS f32x4*)(cw + k * 1536 + c0 + 4);
                    acc[0] += bflo(raw.x) * w0[0]; acc[1] += bfhi(raw.x) * w0[1]; acc[2] += bflo(raw.y) * w0[2]; acc[3] += bfhi(raw.y) * w0[3];
                    acc[4] += bflo(raw.z) * w1[0]; acc[5] += bfhi(raw.z) * w1[1]; acc[6] += bflo(raw.w) * w1[2]; acc[7] += bfhi(raw.w) * w1[3];
                }
            }
            float ss = 0.f;
#pragma unroll
            for (int j = 0; j < 8; ++j) { acc[j] = siluf(acc[j]); ss += acc[j] * acc[j]; }
            if (part < 2) {
                ss += __shfl_xor(ss, 1); ss += __shfl_xor(ss, 2); ss += __shfl_xor(ss, 4); ss += __shfl_xor(ss, 8);
                const float rn = __builtin_amdgcn_rsqf(ss + 1e-6f);
#pragma unroll
                for (int j = 0; j < 8; ++j) acc[j] *= rn;
            }
            u32x4 w; w.x = cvtpk(acc[0], acc[1]); w.y = cvtpk(acc[2], acc[3]); w.z = cvtpk(acc[4], acc[5]); w.w = cvtpk(acc[6], acc[7]);
            *(u32x4*)(QKVC + (size_t)row * 1536 + c0) = w;
        }
        if (lane < 8) {
            const float a = ab_a, bg = ab_b;
            const float xx = a + dtb_;
            const float sp = xx > 20.f ? xx : log1pf(__expf(xx));
            GB[(size_t)row * 16 + lane] = nal_ * sp;
            GB[(size_t)row * 16 + 8 + lane] = sigmoidf(bg);
        }
        bf16_t* cr = CQKV + (size_t)row * 768;
        {
            float q8[8], k8[8]; float sq = 0.f, sk = 0.f;
            if (lane < 48) { const u32x4 raw = rawq;
                q8[0] = bflo(raw.x); q8[1] = bfhi(raw.x); q8[2] = bflo(raw.y); q8[3] = bfhi(raw.y); q8[4] = bflo(raw.z); q8[5] = bfhi(raw.z); q8[6] = bflo(raw.w); q8[7] = bfhi(raw.w);
#pragma unroll
                for (int j = 0; j < 8; ++j) sq += q8[j] * q8[j]; }
            if (lane < 32) { const u32x4 raw = rawk;
                k8[0] = bflo(raw.x); k8[1] = bfhi(raw.x); k8[2] = bflo(raw.y); k8[3] = bfhi(raw.y); k8[4] = bflo(raw.z); k8[5] = bfhi(raw.z); k8[6] = bflo(raw.w); k8[7] = bfhi(raw.w);
#pragma unroll
                for (int j = 0; j < 8; ++j) sk += k8[j] * k8[j]; }
            const u32x4 krw = rawr;
            sq = wave_sum(sq); sk = wave_sum(sk);
            const float rq = __builtin_amdgcn_rsqf(sq * (1.f / 384.f) + EPS), rk = __builtin_amdgcn_rsqf(sk * (1.f / 256.f) + EPS);
            if (lane < 48) { u32x4 w; const float* gp = qg8;
                w.x = cvtpk(q8[0] * rq * gp[0], q8[1] * rq * gp[1]); w.y = cvtpk(q8[2] * rq * gp[2], q8[3] * rq * gp[3]);
                w.z = cvtpk(q8[4] * rq * gp[4], q8[5] * rq * gp[5]); w.w = cvtpk(q8[6] * rq * gp[6], q8[7] * rq * gp[7]);
                *(u32x4*)(cr + lane * 8) = w; }
            if (lane < 32) { u32x4 w; const float* gp = kg8;
                w.x = cvtpk(k8[0] * rk * gp[0], k8[1] * rk * gp[1]); w.y = cvtpk(k8[2] * rk * gp[2], k8[3] * rk * gp[3]);
                w.z = cvtpk(k8[4] * rk * gp[4], k8[5] * rk * gp[5]); w.w = cvtpk(k8[6] * rk * gp[6], k8[7] * rk * gp[7]);
                *(u32x4*)(cr + 384 + lane * 8) = w; }
            if (lane < 4) {
                u32x4 w = krw;
                if (row < ML) {
                    float v[8]; v[0] = bflo(krw.x); v[1] = bfhi(krw.x); v[2] = bflo(krw.y); v[3] = bfhi(krw.y); v[4] = bflo(krw.z); v[5] = bfhi(krw.z); v[6] = bflo(krw.w); v[7] = bfhi(krw.w);
                    const f32x4 cs = rcs, sn = rsn;
#pragma unroll
                    for (int p = 0; p < 4; ++p) { const float a = v[2 * p], bb = v[2 * p + 1]; v[2 * p] = a * cs[p] - bb * sn[p]; v[2 * p + 1] = bb * cs[p] + a * sn[p]; }
                    w.x = cvtpk(v[0], v[1]); w.y = cvtpk(v[2], v[3]); w.z = cvtpk(v[4], v[5]); w.w = cvtpk(v[6], v[7]);
                }
                *(u32x4*)((bf16_t*)(F.ws + WS_KR) + (size_t)row * 32 + lane * 8) = w;
            }
        }
    }
}

DI int gdn_base(int b, int cn) { return cn < 4 ? ML + b * LC + 64 * cn : b * SEQ + 64 * (cn - 4); }
DI void gdn_chunk_unit(Frame& F, int uidx) {
    const int b = uidx / (4 * NCHUNK), h = (uidx / NCHUNK) & 3, cn = uidx % NCHUNK;
    const int base = gdn_base(b, cn);
    const bf16_t* QKVC = (const bf16_t*)(F.ws + WS_QKVC); const float* GB = (const float*)(F.ws + WS_GB);
    bf16_t* GU = (bf16_t*)(F.ws + WS_GU); bf16_t* GW = (bf16_t*)(F.ws + WS_GW); bf16_t* GQK = (bf16_t*)(F.ws + WS_GQK); float* GC = (float*)(F.ws + WS_GC);
    LAS float* As = (LAS float*)F.lds;
    LAS float* gcs = (LAS float*)(F.lds + 32768);
    LAS float* bts = (LAS float*)(F.lds + 32768 + 512);
    LAS float* rfs = (LAS float*)(F.lds + 32768 + 1024);
    int lane = F.lane, tid_ = F.tid; const int wave = F.wave;
    asm volatile("" : "+v"(lane), "+v"(tid_));
    __syncthreads();
    if (wave < 2) {
        const int dir = wave, i = lane, tok = base + (dir ? 63 - i : i);
        float g = GB[(size_t)tok * 16 + dir * 4 + h]; const float bt = GB[(size_t)tok * 16 + 8 + dir * 4 + h];
#pragma unroll
        for (int o = 1; o < 64; o <<= 1) { const float up = __shfl_up(g, o); if (lane >= o) g += up; }
        gcs[dir * 64 + i] = g; bts[dir * 64 + i] = bt;
        rfs[dir * 128 + i] = bt; rfs[dir * 128 + 64 + i] = bt * __expf(g);
        GC[(size_t)((((b * 4 + h) * 2 + dir) * NCHUNK + cn)) * 64 + i] = g;
    }
    __syncthreads();
    const int r = lane & 31, hh = lane >> 5;
    for (int task = wave; task < 12; task += 8) {
        const int dir = task / 6, kind = (task % 6) / 3, blk = task % 3;
        const int bi = blk ? 1 : 0, bj = blk == 2 ? 1 : 0;
        const size_t uid = (size_t)(((b * 4 + h) * 2 + dir) * NCHUNK + cn);
        f32x16 x;
#pragma unroll
        for (int i = 0; i < 16; ++i) x[i] = 0.f;
        if (kind == 0) {
            const int jr = 32 * bj + r, ir = 32 * bi + r;
            const int tokj = base + (dir ? 63 - jr : jr), toki = base + (dir ? 63 - ir : ir);
            const bf16_t* pa = QKVC + (size_t)tokj * 1536 + 512 + h * 128 + 8 * hh;
            const bf16_t* pb = QKVC + (size_t)toki * 1536 + 512 + h * 128 + 8 * hh;
#pragma unroll
            for (int s = 0; s < 8; ++s) { const bf16x8 a = *(const bf16x8*)(pa + 16 * s), bb = *(const bf16x8*)(pb + 16 * s); x = MFMA32(a, bb, x); }
            const float gi = gcs[dir * 64 + ir], bti = bts[dir * 64 + ir];
#pragma unroll
            for (int i = 0; i < 16; ++i) {
                const int jj = 32 * bj + crow(i, hh);
                const float e = __expf(gi - gcs[dir * 64 + jj]);
                As[dir * 4096 + jj * 64 + ir] = (jj < ir) ? bti * x[i] * e : 0.f;
            }
        } else {
            const int ia = 32 * bi + r, jb = 32 * bj + r;
            const int toka = base + (dir ? 63 - ia : ia), tokb = base + (dir ? 63 - jb : jb);
            const bf16_t* pa = QKVC + (size_t)toka * 1536 + h * 128 + 8 * hh;
            const bf16_t* pb = QKVC + (size_t)tokb * 1536 + 512 + h * 128 + 8 * hh;
#pragma unroll
            for (int s = 0; s < 8; ++s) { const bf16x8 a = *(const bf16x8*)(pa + 16 * s), bb = *(const bf16x8*)(pb + 16 * s); x = MFMA32(a, bb, x); }
            const float gj = gcs[dir * 64 + jb];
#pragma unroll
            for (int i = 0; i < 16; ++i) {
                const int ii = 32 * bi + crow(i, hh);
                const float dec = __expf(gcs[dir * 64 + ii] - gj);
                GQK[uid * 4096 + ii * 64 + jb] = (bf16_t)f2bf((jb <= ii) ? x[i] * 0.08838834764831845f * dec : 0.f);
            }
        }
    }
    {
        const int dir = tid_ >> 8, idx = tid_ & 255, i = idx >> 3, j4 = 32 + (idx & 7) * 4;
        const size_t uid = (size_t)(((b * 4 + h) * 2 + dir) * NCHUNK + cn);
        *(u32x2*)(GQK + uid * 4096 + i * 64 + j4) = (u32x2){0u, 0u};
    }
    __syncthreads();
    {
        const int dir = tid_ >> 8, c = tid_ & 255;
        const size_t uid = (size_t)(((b * 4 + h) * 2 + dir) * NCHUNK + cn);
        const LAS float* A = As + dir * 4096;
        f32x2 xp[32];
#define XE(i) xp[(i) >> 1][(i) & 1]
        const bool isw = c >= 128; const int cc = c & 127;
        const bf16_t* src = QKVC + (isw ? 512 : 1024) + h * 128 + cc;
        {
            const bf16_t* pp = src + (size_t)(base + (dir ? 63 : 0)) * 1536;
            const long st = dir ? -1536 : 1536;
#pragma unroll
            for (int i = 0; i < 64; ++i) { XE(i) = bf2f(*pp); pp += st; }
            const LAS float* rf = rfs + dir * 128 + (isw ? 64 : 0);
            __builtin_amdgcn_sched_barrier(0);
#pragma unroll
            for (int i = 0; i < 64; ++i) { XE(i) *= rf[i]; if ((i & 15) == 15) __builtin_amdgcn_sched_barrier(0); }
        }
        f32x4 av[8];
#define SUBST_HALF(j, Q0) do { \
            _Pragma("unroll") for (int q = 0; q < 8; ++q) if ((Q0) + q >= (((j) + 1) >> 2)) av[q] = ((const LAS f32x4*)(A + (j) * 64))[(Q0) + q]; \
            _Pragma("unroll") for (int q = 0; q < 8; ++q) if ((Q0) + q >= (((j) + 1) >> 2)) asm volatile("" : "+v"(av[q])); \
            _Pragma("unroll") for (int q = 0; q < 8; ++q) _Pragma("unroll") for (int k2 = 0; k2 < 2; ++k2) { const int i0 = 4 * ((Q0) + q) + 2 * k2; \
                if (i0 > (j)) xp[i0 >> 1] -= (f32x2){av[q][2 * k2], av[q][2 * k2 + 1]} * (f32x2){xj, xj}; else if (i0 + 1 > (j)) XE(i0 + 1) -= av[q][2 * k2 + 1] * xj; } \
            } while (0)
#define SUBST_COL(j) do { const float xj = XE((j)); if ((j) < 31) SUBST_HALF(j, 0); SUBST_HALF(j, 8); } while (0)
        SUBST_COL(0); SUBST_COL(1); SUBST_COL(2); SUBST_COL(3); SUBST_COL(4); SUBST_COL(5); SUBST_COL(6); SUBST_COL(7);
        SUBST_COL(8); SUBST_COL(9); SUBST_COL(10); SUBST_COL(11); SUBST_COL(12); SUBST_COL(13); SUBST_COL(14); SUBST_COL(15);
        SUBST_COL(16); SUBST_COL(17); SUBST_COL(18); SUBST_COL(19); SUBST_COL(20); SUBST_COL(21); SUBST_COL(22); SUBST_COL(23);
        SUBST_COL(24); SUBST_COL(25); SUBST_COL(26); SUBST_COL(27); SUBST_COL(28); SUBST_COL(29); SUBST_COL(30); SUBST_COL(31);
        SUBST_COL(32); SUBST_COL(33); SUBST_COL(34); SUBST_COL(35); SUBST_COL(36); SUBST_COL(37); SUBST_COL(38); SUBST_COL(39);
        SUBST_COL(40); SUBST_COL(41); SUBST_COL(42); SUBST_COL(43); SUBST_COL(44); SUBST_COL(45); SUBST_COL(46); SUBST_COL(47);
        SUBST_COL(48); SUBST_COL(49); SUBST_COL(50); SUBST_COL(51); SUBST_COL(52); SUBST_COL(53); SUBST_COL(54); SUBST_COL(55);
        SUBST_COL(56); SUBST_COL(57); SUBST_COL(58); SUBST_COL(59); SUBST_COL(60); SUBST_COL(61); SUBST_COL(62);
#undef SUBST_COL
#undef SUBST_HALF
        if (isw) {
            bf16_t* dst = GW + uid * 8192 + cc;
#pragma unroll
            for (int i = 0; i < 64; ++i) dst[i * 128] = (bf16_t)f2bf(-XE(i));
        } else {
            bf16_t* dst = GU + uid * 8192 + (size_t)((cc >> 5) * 2) * 1024 + (cc & 31) * 16;
#pragma unroll
            for (int i = 0; i < 64; ++i) { const int it = i >> 5, ip = i & 31, reg = (ip & 3) + 4 * (ip >> 3), hq = (ip >> 2) & 1;
                dst[it * 1024 + hq * 512 + reg] = (bf16_t)f2bf(XE(i)); }
        }
    }
}

#undef XE
constexpr int SC_NW = 0, SC_QS = 16896, SC_KT = 33792, SC_QM = 51200, SC_BUF = 59904;
DI bf16x8 rd_frag(const LAS unsigned char* p) { const s16x4 lo = *(const LAS s16x4*)p, hi = *(const LAS s16x4*)(p + 16); return __builtin_shufflevector(lo, hi, 0, 1, 2, 3, 4, 5, 6, 7); }
DI bf16x8 pack8(const f32x16& x, int s2) {
    u32x4 p; p.x = cvtpk(x[8 * s2 + 0], x[8 * s2 + 1]); p.y = cvtpk(x[8 * s2 + 2], x[8 * s2 + 3]); p.z = cvtpk(x[8 * s2 + 4], x[8 * s2 + 5]); p.w = cvtpk(x[8 * s2 + 6], x[8 * s2 + 7]);
    return __builtin_bit_cast(bf16x8, p);
}
DI u32x4 scale8(u32x4 v, float f) {
    u32x4 o; o.x = cvtpk(bflo(v.x) * f, bfhi(v.x) * f); o.y = cvtpk(bflo(v.y) * f, bfhi(v.y) * f); o.z = cvtpk(bflo(v.z) * f, bfhi(v.z) * f); o.w = cvtpk(bflo(v.w) * f, bfhi(v.w) * f); return o;
}
DI void gdn_scan(Frame& F, int seq) {
    const int b = seq >> 3, h = (seq >> 1) & 3, dir = seq & 1;
    const bf16_t* QKVC = (const bf16_t*)(F.ws + WS_QKVC);
    const bf16_t* GU = (const bf16_t*)(F.ws + WS_GU); const bf16_t* GW = (const bf16_t*)(F.ws + WS_GW); const bf16_t* GQK = (const bf16_t*)(F.ws + WS_GQK); const float* GC = (const float*)(F.ws + WS_GC);
    bf16_t* OFB = (bf16_t*)(F.ws + WS_OFB) + (size_t)dir * MT * 512;
    const int tid = F.tid, lane = F.lane, wave = F.wave;
    const size_t uid0 = (size_t)(((b * 4 + h) * 2 + dir) * NCHUNK);
#define SC_CN(n) (dir ? ((n) < 4 ? 3 - (n) : 131 - ((n) - 4)) : (n))
    __syncthreads();
    if (wave >= 4) {
        const int lt = tid - 256;
        const int wi = lt >> 4, wch = lt & 15;
        const int ki0 = 4 * (lt >> 4);
        const int mi = lt >> 3, mch = lt & 7;
        u32x4 rw[4], rq[4], rk[4], rm[2]; float gq[4], gk[4], g63 = 0.f;
#define SC_LOAD(n) do { const int cn_ = SC_CN(n); const int base_ = gdn_base(b, cn_); const size_t uid_ = uid0 + cn_; \
            _Pragma("unroll") for (int rep = 0; rep < 4; ++rep) { const int i_ = wi + 16 * rep; const int tok_ = base_ + (dir ? 63 - i_ : i_); \
                rw[rep] = *(const u32x4*)(GW + uid_ * 8192 + i_ * 128 + wch * 8); rq[rep] = *(const u32x4*)(QKVC + (size_t)tok_ * 1536 + h * 128 + wch * 8); gq[rep] = GC[uid_ * 64 + i_]; } \
            _Pragma("unroll") for (int k = 0; k < 4; ++k) { const int i_ = ki0 + k; const int tok_ = base_ + (dir ? 63 - i_ : i_); \
                rk[k] = *(const u32x4*)(QKVC + (size_t)tok_ * 1536 + 512 + h * 128 + wch * 8); gk[k] = GC[uid_ * 64 + i_]; } \
            _Pragma("unroll") for (int rep = 0; rep < 2; ++rep) rm[rep] = *(const u32x4*)(GQK + uid_ * 4096 + (mi + 32 * rep) * 64 + mch * 8); \
            g63 = GC[uid_ * 64 + 63]; } while (0)
#define SC_STORE(bufp) do { LAS unsigned char* bp_ = (bufp); \
            _Pragma("unroll") for (int rep = 0; rep < 4; ++rep) { const int i_ = wi + 16 * rep; \
                LAS unsigned char* d_ = bp_ + SC_NW + i_ * 264 + wch * 16; *(LAS u32x2*)d_ = (u32x2){rw[rep].x, rw[rep].y}; *(LAS u32x2*)(d_ + 8) = (u32x2){rw[rep].z, rw[rep].w}; \
                const u32x4 q_ = scale8(rq[rep], __expf(gq[rep]) * 0.08838834764831845f); \
                LAS unsigned char* e_ = bp_ + SC_QS + i_ * 264 + wch * 16; *(LAS u32x2*)e_ = (u32x2){q_.x, q_.y}; *(LAS u32x2*)(e_ + 8) = (u32x2){q_.z, q_.w}; } \
            { u32x4 ks_[4]; _Pragma("unroll") for (int k = 0; k < 4; ++k) ks_[k] = scale8(rk[k], __expf(g63 - gk[k])); \
              _Pragma("unroll") for (int c = 0; c < 4; ++c) { \
                  const unsigned a0 = ks_[0][c], a1 = ks_[1][c], a2 = ks_[2][c], a3 = ks_[3][c]; \
                  LAS unsigned char* d_ = bp_ + SC_KT + (wch * 8 + 2 * c) * 136 + ki0 * 2; \
                  *(LAS u32x2*)d_ = (u32x2){(a0 & 0xffffu) | (a1 << 16), (a2 & 0xffffu) | (a3 << 16)}; \
                  *(LAS u32x2*)(d_ + 136) = (u32x2){(a0 >> 16) | (a1 & 0xffff0000u), (a2 >> 16) | (a3 & 0xffff0000u)}; } } \
            _Pragma("unroll") for (int rep = 0; rep < 2; ++rep) { LAS unsigned char* d_ = bp_ + SC_QM + (mi + 32 * rep) * 136 + mch * 16; \
                *(LAS u32x2*)d_ = (u32x2){rm[rep].x, rm[rep].y}; *(LAS u32x2*)(d_ + 8) = (u32x2){rm[rep].z, rm[rep].w}; } } while (0)
        SC_LOAD(0); SC_STORE(F.lds); SC_LOAD(1);
        for (int n = 0; n < NCHUNK; ++n) {
            __syncthreads();
            if (n + 1 < NCHUNK) { SC_STORE(F.lds + ((n + 1) & 1) * SC_BUF); }
            if (n + 2 < NCHUNK) { SC_LOAD(n + 2); }
        }
#undef SC_LOAD
#undef SC_STORE
    } else {
        const int r = lane & 31, hh = lane >> 5, c0 = 32 * wave;
        f32x16 S[4];
#pragma unroll
        for (int t = 0; t < 4; ++t)
#pragma unroll
            for (int i = 0; i < 16; ++i) S[t][i] = 0.f;
        u32x4 un[2][2];
#define SC_ULOAD(n) do { const size_t uid_ = uid0 + SC_CN(n); _Pragma("unroll") for (int it = 0; it < 2; ++it) { const u32x4* up_ = (const u32x4*)(GU + uid_ * 8192 + ((size_t)((wave * 2 + it) * 64 + lane)) * 16); un[it][0] = up_[0]; un[it][1] = up_[1]; } } while (0)
        SC_ULOAD(0);
        float gc_next = GC[(uid0 + SC_CN(0)) * 64 + 63];
        for (int n = 0; n < NCHUNK; ++n) {
            __syncthreads();
            const LAS unsigned char* bp = F.lds + (n & 1) * SC_BUF;
            const int cn = SC_CN(n); const int base = gdn_base(b, cn);
            const float gl = __expf(gc_next);
            if (n + 1 < NCHUNK) gc_next = GC[(uid0 + SC_CN(n + 1)) * 64 + 63];
            f32x16 V[2];
#pragma unroll
            for (int it = 0; it < 2; ++it) {
                V[it][0] = bflo(un[it][0].x); V[it][1] = bfhi(un[it][0].x); V[it][2] = bflo(un[it][0].y); V[it][3] = bfhi(un[it][0].y);
                V[it][4] = bflo(un[it][0].z); V[it][5] = bfhi(un[it][0].z); V[it][6] = bflo(un[it][0].w); V[it][7] = bfhi(un[it][0].w);
                V[it][8] = bflo(un[it][1].x); V[it][9] = bfhi(un[it][1].x); V[it][10] = bflo(un[it][1].y); V[it][11] = bfhi(un[it][1].y);
                V[it][12] = bflo(un[it][1].z); V[it][13] = bfhi(un[it][1].z); V[it][14] = bflo(un[it][1].w); V[it][15] = bfhi(un[it][1].w);
            }
            if (n + 1 < NCHUNK) SC_ULOAD(n + 1);
            bf16x8 Sp[4][2];
#pragma unroll
            for (int t = 0; t < 4; ++t) { Sp[t][0] = pack8(S[t], 0); Sp[t][1] = pack8(S[t], 1); }
#define SC_PIN8(fr) do { _Pragma("unroll") for (int k_ = 0; k_ < 8; ++k_) asm volatile("" : "+v"(fr[k_])); } while (0)
#pragma unroll
            for (int it = 0; it < 2; ++it) {
                bf16x8 fr[8];
#pragma unroll
                for (int t = 0; t < 4; ++t)
#pragma unroll
                    for (int s2 = 0; s2 < 2; ++s2) fr[t * 2 + s2] = rd_frag(bp + SC_NW + (32 * it + r) * 264 + (32 * t + 16 * s2 + 4 * hh) * 2);
                SC_PIN8(fr);
#pragma unroll
                for (int t = 0; t < 4; ++t)
#pragma unroll
                    for (int s2 = 0; s2 < 2; ++s2) V[it] = MFMA32(fr[t * 2 + s2], Sp[t][s2], V[it]);
            }
            bf16x8 Vp[2][2];
#pragma unroll
            for (int it = 0; it < 2; ++it) { Vp[it][0] = pack8(V[it], 0); Vp[it][1] = pack8(V[it], 1); }
#pragma unroll
            for (int tp = 0; tp < 2; ++tp) {
                bf16x8 fr[8];
#pragma unroll
                for (int tt = 0; tt < 2; ++tt)
#pragma unroll
                    for (int it = 0; it < 2; ++it)
#pragma unroll
                        for (int s2 = 0; s2 < 2; ++s2) fr[tt * 4 + it * 2 + s2] = rd_frag(bp + SC_KT + (32 * (2 * tp + tt) + r) * 136 + (32 * it + 16 * s2 + 4 * hh) * 2);
                SC_PIN8(fr);
#pragma unroll
                for (int tt = 0; tt < 2; ++tt) { const int t = 2 * tp + tt;
#pragma unroll
                    for (int i = 0; i < 16; ++i) S[t][i] *= gl;
#pragma unroll
                    for (int it = 0; it < 2; ++it)
#pragma unroll
                        for (int s2 = 0; s2 < 2; ++s2) S[t] = MFMA32(fr[tt * 4 + it * 2 + s2], Vp[it][s2], S[t]);
                }
            }
#pragma unroll
            for (int it = 0; it < 2; ++it) {
                f32x16 O;
#pragma unroll
                for (int i = 0; i < 16; ++i) O[i] = 0.f;
                {
                    bf16x8 fr[8], fm[4];
#pragma unroll
                    for (int t = 0; t < 4; ++t)
#pragma unroll
                        for (int s2 = 0; s2 < 2; ++s2) fr[t * 2 + s2] = rd_frag(bp + SC_QS + (32 * it + r) * 264 + (32 * t + 16 * s2 + 4 * hh) * 2);
#pragma unroll
                    for (int jt = 0; jt <= it; ++jt)
#pragma unroll
                        for (int s2 = 0; s2 < 2; ++s2) fm[jt * 2 + s2] = rd_frag(bp + SC_QM + (32 * it + r) * 136 + (32 * jt + 16 * s2 + 4 * hh) * 2);
                    SC_PIN8(fr);
#pragma unroll
                    for (int k_ = 0; k_ < 2 * (it + 1); ++k_) asm volatile("" : "+v"(fm[k_]));
#pragma unroll
                    for (int t = 0; t < 4; ++t)
#pragma unroll
                        for (int s2 = 0; s2 < 2; ++s2) O = MFMA32(fr[t * 2 + s2], Sp[t][s2], O);
#pragma unroll
                    for (int jt = 0; jt <= it; ++jt)
#pragma unroll
                        for (int s2 = 0; s2 < 2; ++s2) O = MFMA32(fm[jt * 2 + s2], Vp[jt][s2], O);
                }
                const unsigned lo_ = (unsigned)((((dir ? -4 * hh : 4 * hh) * 512) + h * 128 + c0 + r) * 2);
                char* ub_ = (char*)OFB + (ptrdiff_t)(base + (dir ? 63 : 0)) * 1024;
                const ptrdiff_t rs_ = dir ? -1024 : 1024;
#pragma unroll
                for (int i = 0; i < 16; ++i) {
                    const int ci = 32 * it + (i & 3) + 8 * (i >> 2);
                    *(bf16_t*)(ub_ + ci * rs_ + (ptrdiff_t)(int)lo_) = (bf16_t)(cvtpk(O[i], 0.f) & 0xffffu);
                }
            }
        }
#undef SC_ULOAD
#undef SC_PIN8
    }
#undef SC_CN
    __syncthreads();
}

DI void gdn_out_rows(Frame& F, int row_begin, int row_end);
DI void phase_gdn_out(Frame& F) {
    const bf16_t* OF = (const bf16_t*)(F.ws + WS_OFB); const bf16_t* OB = OF + (size_t)MT * 512; const bf16_t* Z = (const bf16_t*)(F.ws + WS_Z);
    bf16_t* MIX = (bf16_t*)(F.ws + WS_H);
    const float* gg = F.in[11] + (F.lane & 15) * 8;
    const int gw = F.bid * 8 + F.wave, NGW = F.G * 8;
    for (int row = gw; row < MT; row += NGW) {
        const u32x4 a = *(const u32x4*)(OF + (size_t)row * 512 + F.lane * 8), bq = *(const u32x4*)(OB + (size_t)row * 512 + F.lane * 8), zz = *(const u32x4*)(Z + (size_t)row * 512 + F.lane * 8);
        float o[8], z[8];
        o[0] = bflo(a.x) + bflo(bq.x); o[1] = bfhi(a.x) + bfhi(bq.x); o[2] = bflo(a.y) + bflo(bq.y); o[3] = bfhi(a.y) + bfhi(bq.y);
        o[4] = bflo(a.z) + bflo(bq.z); o[5] = bfhi(a.z) + bfhi(bq.z); o[6] = bflo(a.w) + bflo(bq.w); o[7] = bfhi(a.w) + bfhi(bq.w);
        z[0] = bflo(zz.x); z[1] = bfhi(zz.x); z[2] = bflo(zz.y); z[3] = bfhi(zz.y); z[4] = bflo(zz.z); z[5] = bfhi(zz.z); z[6] = bflo(zz.w); z[7] = bfhi(zz.w);
        float ss = 0.f;
#pragma unroll
        for (int j = 0; j < 8; ++j) ss += o[j] * o[j];
        ss += __shfl_xor(ss, 1); ss += __shfl_xor(ss, 2); ss += __shfl_xor(ss, 4); ss += __shfl_xor(ss, 8);
        const float rn = __builtin_amdgcn_rsqf(ss * (1.f / 128.f) + EPS);
        float y[8];
#pragma unroll
        for (int j = 0; j < 8; ++j) y[j] = o[j] * rn * gg[j] * siluf(z[j]);
        u32x4 w; w.x = cvtpk(y[0], y[1]); w.y = cvtpk(y[2], y[3]); w.z = cvtpk(y[4], y[5]); w.w = cvtpk(y[6], y[7]);
        *(u32x4*)(MIX + (size_t)row * D + F.lane * 8) = w;
    }
}

DI void gdn_out_rows(Frame& F, int row_begin, int row_end) {
    const bf16_t* OF = (const bf16_t*)(F.ws + WS_OFB); const bf16_t* OB = OF + (size_t)MT * 512; const bf16_t* Z = (const bf16_t*)(F.ws + WS_Z);
    bf16_t* MIX = (bf16_t*)(F.ws + WS_H);
    float g8[8];
    { const f32x4 g0 = *(const f32x4*)(F.in[11] + (F.lane & 15) * 8), g1 = *(const f32x4*)(F.in[11] + (F.lane & 15) * 8 + 4);
#pragma unroll
      for (int j = 0; j < 4; ++j) { g8[j] = g0[j]; g8[4 + j] = g1[j]; } }
    for (int row0 = row_begin + F.wave; row0 < row_end; row0 += 32) {
        u32x4 a[4], bq[4], zz[4];
#pragma unroll
        for (int i = 0; i < 4; ++i) { const int row = min(row0 + 8 * i, row_end - 1);
            a[i] = *(const u32x4*)(OF + (size_t)row * 512 + F.lane * 8); bq[i] = *(const u32x4*)(OB + (size_t)row * 512 + F.lane * 8); zz[i] = *(const u32x4*)(Z + (size_t)row * 512 + F.lane * 8); }
#pragma unroll
        for (int i = 0; i < 4; ++i) { const int row = row0 + 8 * i;
            if (row < row_end) {
                float o[8], z[8];
                o[0] = bflo(a[i].x) + bflo(bq[i].x); o[1] = bfhi(a[i].x) + bfhi(bq[i].x); o[2] = bflo(a[i].y) + bflo(bq[i].y); o[3] = bfhi(a[i].y) + bfhi(bq[i].y);
                o[4] = bflo(a[i].z) + bflo(bq[i].z); o[5] = bfhi(a[i].z) + bfhi(bq[i].z); o[6] = bflo(a[i].w) + bflo(bq[i].w); o[7] = bfhi(a[i].w) + bfhi(bq[i].w);
                z[0] = bflo(zz[i].x); z[1] = bfhi(zz[i].x); z[2] = bflo(zz[i].y); z[3] = bfhi(zz[i].y); z[4] = bflo(zz[i].z); z[5] = bfhi(zz[i].z); z[6] = bflo(zz[i].w); z[7] = bfhi(zz[i].w);
                float ss = 0.f;
#pragma unroll
                for (int j = 0; j < 8; ++j) ss += o[j] * o[j];
                ss += __shfl_xor(ss, 1); ss += __shfl_xor(ss, 2); ss += __shfl_xor(ss, 4); ss += __shfl_xor(ss, 8);
                const float rn = __builtin_amdgcn_rsqf(ss * (1.f / 128.f) + EPS);
                float y[8];
#pragma unroll
                for (int j = 0; j < 8; ++j) y[j] = o[j] * rn * g8[j] * siluf(z[j]);
                u32x4 w; w.x = cvtpk(y[0], y[1]); w.y = cvtpk(y[2], y[3]); w.z = cvtpk(y[4], y[5]); w.w = cvtpk(y[6], y[7]);
                *(u32x4*)(MIX + (size_t)row * D + F.lane * 8) = w;
            }
        }
    }
}

DI int dest_row(int kind, int n) {
    switch (kind) {
    case 1: {
        if (n < 2048) return n;
        if (n < 2064) return 2720 + (n - 2048);
        if (n < 2448) return 2048 + (n - 2064);
        if (n < 2704) return 2432 + (n - 2448);
        const int o = n - 2704, q = o >> 3, i = o & 7;
        return 2688 + ((q >> 1) * 16) + 2 * i + (q & 1);
    }
    case 2: {
        const int hd = n / 96, o = n % 96;
        if (o < 64) return n;
        const int oo = o - 64, q = oo >> 3, i = oo & 7;
        return hd * 96 + 64 + ((q >> 1) * 16) + 2 * i + (q & 1);
    }
    case 3: {
        const int hd = n >> 7, o = n & 127;
        return (o < 64 ? 0 : 512) + hd * 64 + (o & 63);
    }
    case 4: return (n >> 7) * 256 + (n & 127);
    case 5: return (n >> 7) * 256 + 128 + (n & 127);
    default: return n;
    }
}
DI void transpose_item(const float* W, int K, int N, bf16_t* WT, int ldk, int kind, LAS float* scr, int item, int lane, float scale = 1.f) {
    const int nblk = (N + 63) / 64, kb = item / nblk, nb = item % nblk, k0 = 64 * kb, n0 = 64 * nb;
    const float* src = W + (size_t)k0 * N + min(n0 + lane, N - 1);
    {
        float v[64];
        const float* sp = src;
#pragma unroll
        for (int i = 0; i < 64; ++i) { v[i] = __builtin_nontemporal_load(sp); sp += N; }
#pragma unroll
        for (int i = 0; i < 64; ++i) scr[i * 65 + lane] = v[i];
    }
    LDS_WAIT(); asm volatile("" ::: "memory");
    const int c = lane & 7;
    float tv[8][8];
#pragma unroll
    for (int j = 0; j < 8; ++j) { const LAS float* s = scr + (8 * c) * 65 + (lane >> 3) + 8 * j;
#pragma unroll
        for (int k = 0; k < 8; ++k) tv[j][k] = s[k * 65]; }
#pragma unroll
    for (int j = 0; j < 8; ++j)
#pragma unroll
        for (int k = 0; k < 8; ++k) asm volatile("" : "+v"(tv[j][k]));
#pragma unroll
    for (int j = 0; j < 8; ++j) { const int n = (lane >> 3) + 8 * j;
        u32x4 o; o.x = cvtpk(tv[j][0] * scale, tv[j][1] * scale); o.y = cvtpk(tv[j][2] * scale, tv[j][3] * scale); o.z = cvtpk(tv[j][4] * scale, tv[j][5] * scale); o.w = cvtpk(tv[j][6] * scale, tv[j][7] * scale);
        if (n0 + n < N) __builtin_nontemporal_store(o, (u32x4*)(WT + (size_t)dest_row(kind, n0 + n) * ldk + k0 + 8 * c)); }
    LDS_WAIT(); asm volatile("" ::: "memory");
}
DI void transpose_item8(const float* W, int K, int N, unsigned char* WT, int ldk, int kind, float scale, LAS float* scr, int item, int lane) {
    const int nblk = (N + 63) / 64, kb = item / nblk, nb = item % nblk, k0 = 64 * kb, n0 = 64 * nb;
    const float* src = W + (size_t)k0 * N + min(n0 + lane, N - 1);
    {
        float v[64];
        const float* sp = src;
#pragma unroll
        for (int i = 0; i < 64; ++i) { v[i] = __builtin_nontemporal_load(sp); sp += N; }
#pragma unroll
        for (int i = 0; i < 64; ++i) scr[i * 65 + lane] = v[i];
    }
    LDS_WAIT(); asm volatile("" ::: "memory");
    const int c = lane & 3;
    float tv[4][16];
#pragma unroll
    for (int j = 0; j < 4; ++j) { const LAS float* s = scr + (16 * c) * 65 + (lane >> 2) + 16 * j;
#pragma unroll
        for (int k = 0; k < 16; ++k) tv[j][k] = s[k * 65]; }
#pragma unroll
    for (int j = 0; j < 4; ++j)
#pragma unroll
        for (int k = 0; k < 16; ++k) asm volatile("" : "+v"(tv[j][k]));
#pragma unroll
    for (int j = 0; j < 4; ++j) { const int n = (lane >> 2) + 16 * j; const float* s = tv[j];
        u32x4 o; o.x = pg8::cvt4_fp8(s[0] * scale, s[1] * scale, s[2] * scale, s[3] * scale); o.y = pg8::cvt4_fp8(s[4] * scale, s[5] * scale, s[6] * scale, s[7] * scale);
        o.z = pg8::cvt4_fp8(s[8] * scale, s[9] * scale, s[10] * scale, s[11] * scale); o.w = pg8::cvt4_fp8(s[12] * scale, s[13] * scale, s[14] * scale, s[15] * scale);
        if (n0 + n < N) __builtin_nontemporal_store(o, (u32x4*)(WT + (size_t)dest_row(kind, n0 + n) * ldk + k0 + 16 * c)); }
    LDS_WAIT(); asm volatile("" ::: "memory");
}
struct CvtJob { const float* W; bf16_t* WT; int K, N, kind, items; };
DI void phase_p0(Frame& F) {
    __syncthreads();
    if (F.bid < 192) {
        LAS float* sv = (LAS float*)F.lds;
        LAS float* red = sv + 3 * 1024;
        for (int i = F.tid; i < 3 * 1024; i += 512) { const float v = i < 2048 ? F.in[1][i] : F.in[3][i - 2048]; sv[i] = siluf(v); }
        __syncthreads();
        const int layer = F.bid / 96, j0 = (F.bid % 96) * 64;
        const float* W = F.in[4] + (size_t)layer * D * 6144 + j0 + F.lane;
        float a0 = 0.f, a1 = 0.f, a2 = 0.f;
        const int kbeg = F.wave * 128;
#pragma unroll 32
        for (int k = kbeg; k < kbeg + 128; ++k) { const float w = W[(size_t)k * 6144]; a0 += sv[k] * w; a1 += sv[1024 + k] * w; a2 += sv[2048 + k] * w; }
        red[(F.wave * 3 + 0) * 64 + F.lane] = a0; red[(F.wave * 3 + 1) * 64 + F.lane] = a1; red[(F.wave * 3 + 2) * 64 + F.lane] = a2;
        __syncthreads();
        if (F.tid < 192) {
            const int r = F.tid >> 6, l = F.tid & 63; float s = 0.f;
#pragma unroll
            for (int w = 0; w < 8; ++w) s += red[(w * 3 + r) * 64 + l];
            ((float*)(F.ws + WS_MOD))[(size_t)(layer * 3 + r) * 6144 + j0 + l] = s + F.in[5][layer * 6144 + j0 + l];
        }
        __syncthreads();
    }
    {
        float* ROPE = (float*)(F.ws + WS_ROPE);
        for (int i = F.bid * 512 + F.tid; i < SEQ * 16; i += F.G * 512) {
            const int t = i >> 4, k = i & 15;
            const float pos = (float)((k < 8) ? (t >> 6) : (t & 63));
            const float inv = powf(10000.f, -(float)(2 * (k & 7)) / 16.f);
            const float ang = pos * inv;
            ROPE[i] = cosf(ang); ROPE[SEQ * 16 + i] = sinf(ang);
        }
    }
    LAS float* scr = (LAS float*)(F.lds + F.wave * 16640);
    const int gw = F.bid * 8 + F.wave, NGW = F.G * 8;
    unsigned char* ws = F.ws;
#define NITEMS(K, N) (((K) / 64) * (((N) + 63) / 64))
    int it = gw;
#define CVT(Wp, WTp, K, N, ldk, kind) do { const int ni = NITEMS(K, N); for (; it < ni; it += NGW) transpose_item((Wp), (K), (N), (WTp), (ldk), (kind), scr, it, F.lane); it -= ni; } while (0)
    CVT(F.in[7], (bf16_t*)(ws + WS_WIN), 1024, 2736, 1024, 1);
    CVT(F.in[13], (bf16_t*)(ws + WS_WUQ), 384, 768, 384, 2);
    CVT(F.in[15], (bf16_t*)(ws + WS_WUKV), 256, 1024, 256, 3);
#undef CVT
#undef NITEMS
}
DI void convert_experts(Frame& F, int gw, int NGW) {
    LAS float* scr = (LAS float*)(F.lds + F.wave * 16640);
    unsigned char* ws = F.ws;
#define NITEMS(K, N) (((K) / 64) * (((N) + 63) / 64))
#define CVT8(Wp, WTp, K, N, ldk, kind, sc) do { const int ni = NITEMS(K, N); for (; it < ni; it += NGW) transpose_item8((Wp), (K), (N), (WTp), (ldk), (kind), (sc), scr, it, F.lane); it -= ni; } while (0)
    int it = gw;
#define CVT(Wp, WTp, K, N, ldk, kind) do { const int ni = NITEMS(K, N); for (; it < ni; it += NGW) transpose_item((Wp), (K), (N), (WTp), (ldk), (kind), scr, it, F.lane, (kind) == 4 ? LOG2E : 1.f); it -= ni; } while (0)
    CVT(F.in[16], (bf16_t*)(ws + WS_WO0), 1024, 1024, 1024, 0);
    CVT(F.in[17], (bf16_t*)(ws + WS_WGU), 1024, 2816, 1024, 4);
    CVT(F.in[18], (bf16_t*)(ws + WS_WGU), 1024, 2816, 1024, 5);
    CVT8(F.in[19], ws + WS_WD, 2816, 1024, 2816, 0, 128.f);
#undef CVT
    CVT8(F.in[22], ws + WS_WO1, 1024, 1024, 1024, 0, 64.f);
    CVT8(F.in[20], ws + WS_WQK1, 1024, 3072, 1024, 0, 64.f);
    for (int e = 0; e < NE; ++e) {
        CVT8(F.in[24] + (size_t)e * D * DFE, ws + WS_WEGU + (size_t)e * 2 * DFE * D, 1024, 3584, 1024, 4, 64.f);
        CVT8(F.in[25] + (size_t)e * D * DFE, ws + WS_WEGU + (size_t)e * 2 * DFE * D, 1024, 3584, 1024, 5, 64.f);
        CVT8(F.in[26] + (size_t)e * DFE * D, ws + WS_WED + (size_t)e * D * DFE, 3584, 1024, 3584, 0, 128.f);
    }
#undef CVT8
#undef NITEMS
}


DI void phase_route(Frame& F, const float* xl) {
    const float* MOD = (const float*)(F.ws + WS_MOD) + (size_t)3 * 6144;
    const float* g = F.in[6] + (size_t)3 * D;
    const float* wr = F.in[23];
    unsigned char* Fb = F.ws + WS_F;
    int* tope = (int*)(F.ws + WS_ROUTE); float* topg = (float*)(F.ws + WS_ROUTE + 131072); int* slot = (int*)(F.ws + WS_ROUTE + 262144);
    unsigned* ecnt = F.ctl + CW_ECNT;
    const int lane = F.lane;
    const int gw = F.bid * 8 + F.wave, NGW = F.G * 8;
    f32x4 wq0[4][4], wq1[4][4];
#pragma unroll
    for (int j = 0; j < 4; ++j)
#pragma unroll
        for (int k = 0; k < 4; ++k) { const int col = 4 * lane + 256 * j + k; wq0[j][k] = *(const f32x4*)(wr + col * 8); wq1[j][k] = *(const f32x4*)(wr + col * 8 + 4); }
    int prow = -1, ps0 = 0, ps1 = 0;
    u32x2 nx[4];
    if (gw < ML) { const u32x2* xr = (const u32x2*)((const bf16_t*)xl + (size_t)gw * D) + lane;
#pragma unroll
        for (int j = 0; j < 4; ++j) nx[j] = xr[64 * j]; }
    for (int row = gw; row < ML; row += NGW) {
        const int r = row < SEQ ? 0 : 1;
        const float* mr = MOD + (size_t)r * 6144 + 3 * D;
        u32x2 cx[4];
#pragma unroll
        for (int j = 0; j < 4; ++j) cx[j] = nx[j];
        if (row + NGW < ML) { const u32x2* xn = (const u32x2*)((const bf16_t*)xl + (size_t)(row + NGW) * D) + lane;
#pragma unroll
            for (int j = 0; j < 4; ++j) nx[j] = xn[64 * j]; }
        f32x4 v[4]; float s = 0.f;
#pragma unroll
        for (int j = 0; j < 4; ++j) { const u32x2 a = cx[j]; v[j] = (f32x4){bflo(a.x), bfhi(a.x), bflo(a.y), bfhi(a.y)}; s += (v[j].x * v[j].x + v[j].y * v[j].y) + (v[j].z * v[j].z + v[j].w * v[j].w); }
        const float rs = __builtin_amdgcn_rsqf(wave_sum(s) * (1.f / D) + EPS);
        float lg[8];
#pragma unroll
        for (int e = 0; e < 8; ++e) lg[e] = 0.f;
        unsigned* o8 = (unsigned*)(Fb + (size_t)row * D) + lane;
        f32x4 gg_[4], cc_[4], hh_[4];
#pragma unroll
        for (int j = 0; j < 4; ++j) { gg_[j] = ((const f32x4*)g)[lane + 64 * j]; cc_[j] = ((const f32x4*)(mr + D))[lane + 64 * j]; hh_[j] = ((const f32x4*)mr)[lane + 64 * j]; }
#pragma unroll
        for (int j = 0; j < 4; ++j) {
            const f32x4 gg = gg_[j], cc = cc_[j], hh = hh_[j];
            f32x4 y;
#pragma unroll
            for (int k = 0; k < 4; ++k) {
                y[k] = v[j][k] * rs * gg[k] * (1.f + cc[k]) + hh[k];
                const f32x4 w0 = wq0[j][k], w1 = wq1[j][k];
                lg[0] += y[k] * w0[0]; lg[1] += y[k] * w0[1]; lg[2] += y[k] * w0[2]; lg[3] += y[k] * w0[3];
                lg[4] += y[k] * w1[0]; lg[5] += y[k] * w1[1]; lg[6] += y[k] * w1[2]; lg[7] += y[k] * w1[3];
            }
            o8[64 * j] = pg8::cvt4_fp8(y[0] * 8.f, y[1] * 8.f, y[2] * 8.f, y[3] * 8.f);
        }
#pragma unroll
        for (int e = 0; e < 8; ++e) lg[e] = wave_sum(lg[e]);
        int e0 = 0; float v0 = lg[0];
#pragma unroll
        for (int e = 1; e < 8; ++e) if (lg[e] > v0) { v0 = lg[e]; e0 = e; }
        int e1 = -1; float v1 = -3.0e38f;
#pragma unroll
        for (int e = 0; e < 8; ++e) if (e != e0 && lg[e] > v1) { v1 = lg[e]; e1 = e; }
        if (lane == 0) {
            const float p1 = __expf(v1 - v0), inv = 1.f / (1.f + p1);
            tope[row * 2] = e0; tope[row * 2 + 1] = e1; topg[row * 2] = inv; topg[row * 2 + 1] = p1 * inv;
            const int a0 = (int)atomicAdd(&ecnt[64 * e0], 1u), a1 = (int)atomicAdd(&ecnt[64 * e1], 1u);
            if (prow >= 0) { slot[prow * 2] = ps0; slot[prow * 2 + 1] = ps1; }
            prow = row; ps0 = a0; ps1 = a1;
        }
    }
    if (lane == 0 && prow >= 0) { slot[prow * 2] = ps0; slot[prow * 2 + 1] = ps1; }
}
DI void phase_scatter(Frame& F) {
    const unsigned char* Fb = F.ws + WS_F; unsigned char* FS = F.ws + WS_FS;
    const int* tope = (const int*)(F.ws + WS_ROUTE); const int* slot = (const int*)(F.ws + WS_ROUTE + 262144); int* pos = (int*)(F.ws + WS_ROUTE + 393216);
    const unsigned* ecnt = F.ctl + CW_ECNT;
    int off[8]; { int t = 0;
#pragma unroll
        for (int e = 0; e < 8; ++e) { off[e] = t; t += (((int)ecnt[64 * e] + 255) >> 8) << 8; } }
    const int gw = F.bid * 8 + F.wave, NGW = F.G * 8;
    for (int row0 = gw; row0 < ML; row0 += 4 * NGW) {
        u32x4 a[4]; int ee[4][2], ss[4][2];
#pragma unroll
        for (int i = 0; i < 4; ++i) { const int row = min(row0 + i * NGW, ML - 1);
            a[i] = *((const u32x4*)(Fb + (size_t)row * D) + F.lane);
#pragma unroll
            for (int k = 0; k < 2; ++k) { ee[i][k] = tope[row * 2 + k]; ss[i][k] = slot[row * 2 + k]; } }
#pragma unroll
        for (int i = 0; i < 4; ++i) { const int row = row0 + i * NGW;
            if (row < ML) {
#pragma unroll
                for (int k = 0; k < 2; ++k) {
                    const int e = ee[i][k]; int o = 0;
#pragma unroll
                    for (int q = 0; q < 8; ++q) o = (q == e) ? off[q] : o;
                    const int p = o + ss[i][k];
                    *((u32x4*)(FS + (size_t)p * D) + F.lane) = a[i];
                    if (F.lane == 0) pos[row * 2 + k] = p;
                }
            }
        }
    }
}
DI void phase_combine(Frame& F, const bf16_t* xl, float* outp) {
    const float* MOD = (const float*)(F.ws + WS_MOD) + (size_t)3 * 6144;
    const bf16_t* Y = (const bf16_t*)(F.ws + WS_FS);
    const float* topg = (const float*)(F.ws + WS_ROUTE + 131072); const int* pos = (const int*)(F.ws + WS_ROUTE + 393216);
    const float* fg = F.in[27];
    const bf16_t* PY = (const bf16_t*)(F.ws + WS_PARTY);
    int row0t; { pg8::MoeDownOrder S; S.init_down(F.ctl + CW_ECNT, F.G, 0); row0t = S.mt0 * 256; }
    const int lane = F.lane;
    const int gw = F.bid * 8 + F.wave, NGW = F.G * 8;
    int np0 = 0, np1 = 0; float nw0 = 0.f, nw1 = 0.f;
    if (gw < ML) { np0 = pos[gw * 2]; np1 = pos[gw * 2 + 1]; nw0 = topg[gw * 2]; nw1 = topg[gw * 2 + 1]; }
    for (int row = gw; row < ML; row += NGW) {
        const int r = row < SEQ ? 0 : 1;
        const float* g2 = MOD + (size_t)r * 6144 + 5 * D;
        const int p0 = __builtin_amdgcn_readfirstlane(np0), p1 = __builtin_amdgcn_readfirstlane(np1); const float w0 = nw0, w1 = nw1;
        { const int nr = min(row + NGW, ML - 1); np0 = pos[nr * 2]; np1 = pos[nr * 2 + 1]; nw0 = topg[nr * 2]; nw1 = topg[nr * 2 + 1]; }
        const u32x2* xr = (const u32x2*)(xl + (size_t)row * D) + lane; f32x4* orow = (f32x4*)(outp + (size_t)row * D) + lane;
        u32x2 xraw[4], ra[2][4], rb[2][4]; float wb[2];
#pragma unroll
        for (int j = 0; j < 4; ++j) xraw[j] = xr[64 * j];
#pragma unroll
        for (int k = 0; k < 2; ++k) {
            const int pp = k ? p1 : p0; const bool tail = pp >= row0t;
            const u32x2* ypa = (const u32x2*)(tail ? PY + (size_t)(pp - row0t) * D : Y + (size_t)pp * D) + lane;
            const u32x2* ypb = tail ? ypa + (size_t)(2048 * 1024 / 4) : ypa;
            wb[k] = tail ? 1.f : 0.f;
#pragma unroll
            for (int j = 0; j < 4; ++j) { ra[k][j] = ypa[64 * j]; rb[k][j] = ypb[64 * j]; }
        }
        f32x4 ya[4], yb[4];
#pragma unroll
        for (int j = 0; j < 4; ++j) {
            ya[j] = (f32x4){bflo(ra[0][j].x), bfhi(ra[0][j].x), bflo(ra[0][j].y), bfhi(ra[0][j].y)} + wb[0] * (f32x4){bflo(rb[0][j].x), bfhi(rb[0][j].x), bflo(rb[0][j].y), bfhi(rb[0][j].y)};
            yb[j] = (f32x4){bflo(ra[1][j].x), bfhi(ra[1][j].x), bflo(ra[1][j].y), bfhi(ra[1][j].y)} + wb[1] * (f32x4){bflo(rb[1][j].x), bfhi(rb[1][j].x), bflo(rb[1][j].y), bfhi(rb[1][j].y)};
        }
        f32x4 v[4]; float s = 0.f;
#pragma unroll
        for (int j = 0; j < 4; ++j) {
            const u32x2 xa = xraw[j]; const f32x4 x = (f32x4){bflo(xa.x), bfhi(xa.x), bflo(xa.y), bfhi(xa.y)}, gg = ((const f32x4*)g2)[lane + 64 * j];
            v[j] = x + gg * (w0 * ya[j] + w1 * yb[j]);
            s += (v[j].x * v[j].x + v[j].y * v[j].y) + (v[j].z * v[j].z + v[j].w * v[j].w);
        }
        const float rs = __builtin_amdgcn_rsqf(wave_sum(s) * (1.f / D) + EPS);
        f32x4 fg_[4];
#pragma unroll
        for (int j = 0; j < 4; ++j) fg_[j] = ((const f32x4*)fg)[lane + 64 * j];
#pragma unroll
        for (int j = 0; j < 4; ++j) __builtin_nontemporal_store(v[j] * rs * fg_[j], orow + 64 * j);
    }
}

constexpr int NPHASE = 20;
constexpr int NCVT_WG = 48;
#ifndef PROBE_PH
#define PROBE_PH -1
#endif
#define REPS(k) ((PROBE_PH == (k)) ? 2 : 1)
struct Args { const float* in[28]; float* out; unsigned char* ws; int ph_lo, ph_hi; };
__global__ void __launch_bounds__(512, 2) fwd_kernel(Args a) {
    extern __shared__ __attribute__((aligned(16))) unsigned char lds_raw[];
    Frame F;
    F.lds = (LAS unsigned char*)lds_raw;
    F.MISC = (volatile LAS unsigned*)(F.lds + MISC_OFF);
    F.tid = threadIdx.x; F.lane = F.tid & 63; F.wave = __builtin_amdgcn_readfirstlane(F.tid >> 6);
    F.G = gridDim.x; F.bid = blockIdx.x;
    F.ws = a.ws; F.ctl = (unsigned*)(a.ws + WS_CTL); F.out = a.out;
    F.in = a.in;
    if (F.tid < 128) F.MISC[F.tid] = 0u;
    __syncthreads();
    XcdBarrier bar = xcd_barrier_post(F.ctl + CW_BAR, F.MISC + 8);
    const int lo = a.ph_lo, hi = a.ph_hi;
#define IN(k) (lo <= (k) && (k) < hi)
#define SEAM(k) do { if (IN(k) && IN((k) + 1)) xcd_barrier(bar); } while (0)
    unsigned char* ws = a.ws;
    bf16_t* XLB = (bf16_t*)(ws + WS_XLB); float* XC = (float*)(ws + WS_XC);
    bf16_t* H = (bf16_t*)(ws + WS_H);
    const float* MOD0 = (const float*)(ws + WS_MOD); const float* MOD1 = MOD0 + 3 * 6144;
    LAS unsigned char* ring = F.lds;

    if (IN(0)) { for (int rep = 0; rep < REPS(0); ++rep) phase_p0(F); }
    SEAM(0);
    if (IN(1)) phase_norm_mod(F, F.in[0], F.in[2], MT, 0, 0, H, nullptr, 0, nullptr, nullptr);
    SEAM(1);
    if (IN(2)) {
        pg8::Gemm g{H, (const bf16_t*)(ws + WS_WIN), 1024, 1024, 1024, 0};
        pg8::StaticOrder S; S.init(MT, NPROJ, F.G, F.bid);
        pg8::EpiWin E{(bf16_t*)(ws + WS_QKVP), (bf16_t*)(ws + WS_Z), (bf16_t*)(ws + WS_CQKV), (float*)(ws + WS_AB)};
        pg8::gemm_phase(ring, g, S, E);
    }
    SEAM(2);
    if (IN(3)) phase_prep(F);
    SEAM(3);
    if (IN(4)) {
        { pg8::Gemm g{(const bf16_t*)(ws + WS_CQKV), (const bf16_t*)(ws + WS_WUQ), 768, 384, 384, 0};
          pg8::StaticOrder S; S.init(MT, 768, F.G, F.bid);
          pg8::EpiBf16 E{(bf16_t*)(ws + WS_MLAQ), 768};
          pg8::gemm_phase(ring, g, S, E); }
        { pg8::Gemm g{(const bf16_t*)(ws + WS_CQKV) + 384, (const bf16_t*)(ws + WS_WUKV), 768, 256, 256, 0};
          pg8::StaticOrder S; S.init(MT, 512, F.G, F.bid);
          pg8::EpiBf16 E{(bf16_t*)(ws + WS_KN), 512};
          pg8::gemm_phase(ring, g, S, E); }
        { pg8::Gemm g{(const bf16_t*)(ws + WS_WUKV) + (size_t)512 * 256, (const bf16_t*)(ws + WS_CQKV) + 384, 256, 768, 256, 0};
          pg8::StaticOrder S; S.init(512, MT, F.G, F.bid);
          pg8::EpiBf16 E{(bf16_t*)(ws + WS_VT), MT};
          pg8::gemm_phase(ring, g, S, E); }
#define GQOFF 0
        {
            __syncthreads();
            if (F.tid == 0) F.MISC[0] = atomicAdd(F.ctl + CW_GDNQ + GQOFF, 1u);
            __syncthreads();
            int u = (int)F.MISC[0];
            while (u < NB * 4 * NCHUNK) {
                unsigned nxt_ = 0u;
                if (F.tid == 0) nxt_ = atomicAdd(F.ctl + CW_GDNQ + GQOFF, 1u);
                gdn_chunk_unit(F, u);
                __syncthreads();
                if (F.tid == 0) F.MISC[0] = nxt_;
                __syncthreads();
                u = (int)F.MISC[0];
            }
        }
#undef GQOFF
    }
#if PROBE_PH == 4
    if (IN(4)) {
        { pg8::Gemm g{(const bf16_t*)(ws + WS_CQKV), (const bf16_t*)(ws + WS_WUQ), 768, 384, 384, 0};
          pg8::StaticOrder S; S.init(MT, 768, F.G, F.bid);
          pg8::EpiBf16 E{(bf16_t*)(ws + WS_MLAQ), 768};
          pg8::gemm_phase(ring, g, S, E); }
        { pg8::Gemm g{(const bf16_t*)(ws + WS_CQKV) + 384, (const bf16_t*)(ws + WS_WUKV), 768, 256, 256, 0};
          pg8::StaticOrder S; S.init(MT, 512, F.G, F.bid);
          pg8::EpiBf16 E{(bf16_t*)(ws + WS_KN), 512};
          pg8::gemm_phase(ring, g, S, E); }
        { pg8::Gemm g{(const bf16_t*)(ws + WS_WUKV) + (size_t)512 * 256, (const bf16_t*)(ws + WS_CQKV) + 384, 256, 768, 256, 0};
          pg8::StaticOrder S; S.init(512, MT, F.G, F.bid);
          pg8::EpiBf16 E{(bf16_t*)(ws + WS_VT), MT};
          pg8::gemm_phase(ring, g, S, E); }
#define GQOFF 64
        for (;;) {
            __syncthreads();
            if (F.tid == 0) F.MISC[0] = atomicAdd(F.ctl + CW_GDNQ + GQOFF, 1u);
            __syncthreads();
            const int u = (int)F.MISC[0];
            if (u >= NB * 4 * NCHUNK) break;
            gdn_chunk_unit(F, u);
        }
#undef GQOFF
    }
#endif
    SEAM(4);
#define QOFF 0
    if (IN(5)) {
        if (F.bid < 16) {
            gdn_scan(F, F.bid);
            asm volatile("s_waitcnt vmcnt(0)" ::: "memory"); __syncthreads();
            if (F.tid == 0 && QOFF == 0) { __builtin_amdgcn_fence(__ATOMIC_RELEASE, "agent"); asm volatile("s_waitcnt vmcnt(0)" ::: "memory"); (void)xb_add(F.ctl + CW_SCANDONE, 1u); }
        }
        else if (F.bid < 16 + NCVT_WG && QOFF == 0) { __syncthreads(); convert_experts(F, (F.bid - 16) * 8 + F.wave, NCVT_WG * 8); __syncthreads(); }
        {
            __syncthreads();
            if (F.tid == 0) F.MISC[0] = atomicAdd(F.ctl + CW_QUEUE + QOFF, 1u);
            __syncthreads();
            int u = (int)F.MISC[0];
            while (u < 1056) {
                unsigned nxt_ = 0u;
                if (F.tid == 0) nxt_ = atomicAdd(F.ctl + CW_QUEUE + QOFF, 1u);
                if (u < 1024) mla_unit(F, u >> 9, (u >> 6) & 7, u & 63);
                else mla_unit(F, (u - 1024) >> 4, ((u - 1024) >> 1) & 7, -1 - ((u - 1024) & 1));
                __syncthreads();
                if (F.tid == 0) F.MISC[0] = nxt_;
                __syncthreads();
                u = (int)F.MISC[0];
            }
        }
        {
            __syncthreads();
            if (F.tid == 0) { unsigned* sd = F.ctl + CW_SCANDONE; XB_SPIN(xb_ld(sd) < 16u, F.ctl + CW_BAR); __builtin_amdgcn_fence(__ATOMIC_ACQUIRE, "agent"); asm volatile("s_waitcnt vmcnt(0)" ::: "memory"); }
            __syncthreads();
            for (;;) {
                __syncthreads();
                if (F.tid == 0) F.MISC[0] = atomicAdd(F.ctl + CW_GOQ, 1u);
                __syncthreads();
                const int it = (int)F.MISC[0];
                if (it >= MT / 64) break;
                gdn_out_rows(F, it * 64, it * 64 + 64);
            }
        }
    }
#undef QOFF
#if PROBE_PH == 5
#define QOFF 64
    if (IN(5)) {
        if (F.bid < 16) {
            gdn_scan(F, F.bid);
            asm volatile("s_waitcnt vmcnt(0)" ::: "memory"); __syncthreads();
            if (F.tid == 0 && QOFF == 0) { __builtin_amdgcn_fence(__ATOMIC_RELEASE, "agent"); asm volatile("s_waitcnt vmcnt(0)" ::: "memory"); (void)xb_add(F.ctl + CW_SCANDONE, 1u); }
        }
        else if (F.bid < 16 + NCVT_WG && QOFF == 0) { __syncthreads(); convert_experts(F, (F.bid - 16) * 8 + F.wave, NCVT_WG * 8); __syncthreads(); }
        for (;;) {
            __syncthreads();
            if (F.tid == 0) F.MISC[0] = atomicAdd(F.ctl + CW_QUEUE + QOFF, 1u);
            __syncthreads();
            const int u = (int)F.MISC[0];
            if (u >= 1056) break;
            if (u < 1024) mla_unit(F, u >> 9, (u >> 6) & 7, u & 63);
            else mla_unit(F, (u - 1024) >> 4, ((u - 1024) >> 1) & 7, -1 - ((u - 1024) & 1));
        }
    }
#undef QOFF
#endif
    SEAM(5);
    if (IN(7)) {
        { pg8::Gemm g{H, (const bf16_t*)(ws + WS_WO0), 1024, 1024, 1024, 0, 0};
          pg8::StaticOrder S; S.init(ML, 1024, F.G, F.bid);
          pg8::EpiResidB<true> E{F.in[0], XLB, MOD0 + 2 * D, 1.f};
          pg8::gemm_phase<false, true>(ring, g, S, E); }
        { pg8::Gemm g{H + (size_t)ML * D, (const bf16_t*)(ws + WS_WO0), 1024, 1024, 256, 512, 512};
          pg8::SplitKOrder S; S.init(4, F.G, (F.bid + 128) % F.G);
          pg8::EpiPartial E{(float*)(ws + WS_PART), 1.f};
          pg8::gemm_phase(ring, g, S, E); }
    }
    SEAM(7);
    if (IN(8)) phase_norm_mod<true>(F, (const float*)XLB, F.in[2], MT, 0, 1, H, (const float*)(ws + WS_PART), 4, MOD0 + 2 * 6144 + 2 * D, XC);
    SEAM(8);
    if (IN(9)) {
        pg8::Gemm g{H, (const bf16_t*)(ws + WS_WGU), 1024, 1024, 1024, 0};
        pg8::StaticOrder S; S.init(MT, 2 * DFF, F.G, F.bid);
        pg8::EpiSwigluQ8 E{ws + WS_ACT, DFF};
        pg8::gemm_phase(ring, g, S, E);
    }
    SEAM(9);
    if (IN(10)) {
        { pg8::Gemm g{(const bf16_t*)(ws + WS_ACT), (const bf16_t*)(ws + WS_WD), DFF, DFF, DFF, 0, 0};
          pg8::StaticOrder S; S.init(ML, 1024, F.G, F.bid);
          pg8::EpiResidB<false> E{XLB, XLB, MOD0 + 5 * D, 1.f / 1024.f};
          pg8::gemm_phase<true, true>(ring, g, S, E); }
        { pg8::Gemm g{(const bf16_t*)(ws + WS_ACT + (size_t)ML * DFF), (const bf16_t*)(ws + WS_WD), DFF, DFF, 256, 256, 256};
          pg8::SplitKOrder S; S.init(11, F.G, (F.bid + 128) % F.G);
          pg8::EpiPartial E{(float*)(ws + WS_PART), 1.f / 1024.f};
          pg8::gemm_phase<true>(ring, g, S, E); }
    }
    SEAM(10);
    if (IN(11)) phase_norm_mod<true, true>(F, (const float*)XLB, XC, MT, 1, 0, H, (const float*)(ws + WS_PART), 11, MOD0 + 2 * 6144 + 5 * D, nullptr);
    SEAM(11);
    if (IN(12)) {
        const bf16_t* H8 = H; const bf16_t* W8 = (const bf16_t*)(ws + WS_WQK1);
        { pg8::Gemm g{H8, W8, 1024, 1024, 1024, 0, 0};
          pg8::StaticOrder S; S.init(ML, 2048, F.G, F.bid);
          pg8::EpiBf16S E{(bf16_t*)(ws + WS_QK1), 2048, 1.f / 512.f};
          pg8::gemm_phase<true>(ring, g, S, E); }
        { pg8::Gemm g{(const bf16_t*)((const unsigned char*)W8 + (size_t)2048 * 1024), H8, 1024, 1024, 1024, 0, 0};
          pg8::StaticOrder S; S.init(1024, ML, F.G, F.bid);
          pg8::EpiBf16S E{(bf16_t*)(ws + WS_VT1), MT, 1.f / 512.f};
          pg8::gemm_phase<true>(ring, g, S, E); }
        { pg8::Gemm g{(const bf16_t*)((const unsigned char*)H8 + (size_t)ML * 1024), (const bf16_t*)((const unsigned char*)W8 + (size_t)1024 * 1024), 1024, 1024, 1024, 0, 0};
          pg8::StaticOrder S; S.init(MC, 1024, F.G, (F.bid + 64) % F.G);
          pg8::EpiBf16S E{(bf16_t*)(ws + WS_QK1) + (size_t)ML * 2048 + 1024, 2048, 1.f / 512.f};
          pg8::gemm_phase<true>(ring, g, S, E); }
        { pg8::Gemm g{(const bf16_t*)((const unsigned char*)W8 + (size_t)2048 * 1024), (const bf16_t*)((const unsigned char*)H8 + (size_t)ML * 1024), 1024, 1024, 1024, 0, 0};
          pg8::StaticOrder S; S.init(1024, MC, F.G, (F.bid + 192) % F.G);
          pg8::EpiBf16S E{(bf16_t*)(ws + WS_VT1) + ML, MT, 1.f / 512.f};
          pg8::gemm_phase<true>(ring, g, S, E); }
    }
    SEAM(12);
    if (IN(13)) { for (int rep = 0; rep < REPS(13); ++rep) for (int u = F.bid; u < 1024; u += F.G) na_unit(F, u >> 9, (u >> 5) & 15, u & 31); }
    SEAM(13);
    if (IN(14)) {
        pg8::Gemm g{(const bf16_t*)(ws + WS_O1), (const bf16_t*)(ws + WS_WO1), 1024, 1024, 1024, 0, 0};
        pg8::StaticOrder S; S.init(ML, 1024, F.G, F.bid);
        pg8::EpiResidB<false> E{XLB, XLB, MOD1 + 2 * D, 1.f / 512.f};
        pg8::gemm_phase<true, true>(ring, g, S, E);
    }
    SEAM(14);
    if (IN(15)) phase_route(F, (const float*)XLB);
    SEAM(15);
    if (IN(16)) phase_scatter(F);
    SEAM(16);
    if (IN(17)) {
        pg8::Gemm g{(const bf16_t*)(ws + WS_FS), (const bf16_t*)(ws + WS_WEGU), 1024, 1024, 1024, (size_t)2 * DFE * D, 0};
        pg8::MoeOrder S; S.init_moe(F.ctl + CW_ECNT, 2 * DFE, F.G, F.bid);
        pg8::EpiSwigluF8 E{ws + WS_ACTS, DFE, 1.f / 512.f, 8.f};
        pg8::gemm_phase<true>(ring, g, S, E);
    }
#if PROBE_PH == 17
    if (IN(17)) {
        pg8::Gemm g{(const bf16_t*)(ws + WS_FS), (const bf16_t*)(ws + WS_WEGU), 1024, 1024, 1024, (size_t)2 * DFE * D, 0};
        pg8::MoeOrder S; S.init_moe(F.ctl + CW_ECNT, 2 * DFE, F.G, F.bid);
        pg8::EpiSwigluF8 E{ws + WS_ACTS, DFE, 1.f / 512.f, 8.f};
        pg8::gemm_phase<true>(ring, g, S, E);
    }
#endif
    SEAM(17);
    if (IN(18)) {
        { pg8::Gemm g{(const bf16_t*)(ws + WS_ACTS), (const bf16_t*)(ws + WS_WED), DFE, DFE, DFE, (size_t)D * DFE, 0};
          pg8::MoeDownOrder S; S.init_down(F.ctl + CW_ECNT, F.G, F.bid);
          pg8::EpiBf16S E{(bf16_t*)(ws + WS_FS), 1024, 1.f / 1024.f};
          pg8::gemm_phase<true>(ring, g, S, E); }
        { pg8::Gemm g{(const bf16_t*)(ws + WS_ACTS), (const bf16_t*)(ws + WS_WED), DFE, DFE, 1792, (size_t)D * DFE, 0};
          pg8::MoeTailOrder S; S.init_down(F.ctl + CW_ECNT, F.G, (F.bid + 128) % F.G);
          pg8::EpiMoeTail E{(bf16_t*)(ws + WS_PARTY), S.mt0 * 256, 1.f / 1024.f};
          pg8::gemm_phase<true>(ring, g, S, E); }
    }
#if PROBE_PH == 18
    if (IN(18)) {
        { pg8::Gemm g{(const bf16_t*)(ws + WS_ACTS), (const bf16_t*)(ws + WS_WED), DFE, DFE, DFE, (size_t)D * DFE, 0};
          pg8::MoeDownOrder S; S.init_down(F.ctl + CW_ECNT, F.G, F.bid);
          pg8::EpiBf16S E{(bf16_t*)(ws + WS_FS), 1024, 1.f / 1024.f};
          pg8::gemm_phase<true>(ring, g, S, E); }
        { pg8::Gemm g{(const bf16_t*)(ws + WS_ACTS), (const bf16_t*)(ws + WS_WED), DFE, DFE, 1792, (size_t)D * DFE, 0};
          pg8::MoeTailOrder S; S.init_down(F.ctl + CW_ECNT, F.G, (F.bid + 128) % F.G);
          pg8::EpiMoeTail E{(bf16_t*)(ws + WS_PARTY), S.mt0 * 256, 1.f / 1024.f};
          pg8::gemm_phase<true>(ring, g, S, E); }
    }
#endif
    SEAM(18);
    if (IN(19)) phase_combine(F, XLB, a.out);
#undef IN
#undef SEAM
}

#ifndef MK_MULTI
#define MK_MULTI 0
#endif
extern "C" void kernel_launch(void* const* d_in, const int* in_sizes, int n_in, void* d_out, int out_size, void* d_ws, size_t ws_size, hipStream_t stream) {
    static int grid = 0;
    if (grid == 0) {
        if (n_in != 28 || out_size != ML * D || ws_size < WS_END) { fprintf(stderr, "kernel_launch: unexpected shapes (n_in %d out %d ws %zu need %zu)\n", n_in, out_size, ws_size, (size_t)WS_END); grid = -1; return; }
        int dev = 0, cus = 0, per_cu = 0;
        if (hipGetDevice(&dev) != hipSuccess || hipDeviceGetAttribute(&cus, hipDeviceAttributeMultiprocessorCount, dev) != hipSuccess) { grid = -1; return; }
        if (hipFuncSetAttribute((const void*)fwd_kernel, hipFuncAttributeMaxDynamicSharedMemorySize, LDS_BYTES) != hipSuccess) { fprintf(stderr, "kernel_launch: hipFuncSetAttribute failed\n"); grid = -1; return; }
        if (hipOccupancyMaxActiveBlocksPerMultiprocessor(&per_cu, (const void*)fwd_kernel, 512, LDS_BYTES) != hipSuccess || per_cu < 1) { fprintf(stderr, "kernel_launch: occupancy query says %d\n", per_cu); }
        (void)hipGetLastError();
        grid = cus;
        if (grid < 128) { grid = -1; return; }
    }
    if (grid < 0) return;
    (void)hipMemsetAsync((char*)d_ws + WS_CTL, 0, CTL_BYTES, stream);
    Args a{};
    for (int i = 0; i < 28; ++i) a.in[i] = (const float*)d_in[i];
    a.out = (float*)d_out; a.ws = (unsigned char*)d_ws;
#if MK_MULTI
    for (int p = 0; p < NPHASE; ++p) { a.ph_lo = p; a.ph_hi = p + 1; hipLaunchKernelGGL(fwd_kernel, dim3(grid), dim3(512), LDS_BYTES, stream, a); }
#else
    a.ph_lo = 0; a.ph_hi = NPHASE;
    hipLaunchKernelGGL(fwd_kernel, dim3(grid), dim3(512), LDS_BYTES, stream, a);
#endif
}
```

```cpp
#include <hip/hip_runtime.h>
#include <stdint.h>
#include <stdio.h>

#define GAS __attribute__((address_space(1)))
#define LAS __attribute__((address_space(3)))
typedef unsigned short bf16_t;
typedef short bf16x8 __attribute__((ext_vector_type(8)));
typedef short s16x4 __attribute__((ext_vector_type(4)));
typedef float f32x4 __attribute__((ext_vector_type(4)));
typedef float f32x16 __attribute__((ext_vector_type(16)));
typedef unsigned u32x4 __attribute__((ext_vector_type(4)));
typedef unsigned u32x2 __attribute__((ext_vector_type(2)));
#define DI __device__ __forceinline__

constexpr int D = 1024, NB = 2, SEQ = 8192, LC = 256;
constexpr int ML = NB * SEQ;
constexpr int MC = NB * LC;
constexpr int MT = ML + MC;
constexpr int NPROJ = 2816;
constexpr int DFF = 2816, DFE = 3584, NE = 8;
constexpr int MOE_ROWS = 34816;
constexpr int NCHUNK = 132;
constexpr float EPS = 1e-6f;

constexpr size_t MiB = 1u << 20;
constexpr size_t WS_CTL = 0, CTL_BYTES = 1 * MiB;
constexpr size_t WS_MOD = 1 * MiB;
constexpr size_t WS_ROPE = 2 * MiB;
constexpr size_t WS_GB = 3 * MiB;
constexpr size_t WS_AB = 5 * MiB;
constexpr size_t WS_ROUTE = 7 * MiB;
constexpr size_t WS_XC = 8 * MiB;
constexpr size_t WS_GC = 10 * MiB;
constexpr size_t WS_KR = 11 * MiB;
constexpr size_t WS_WQK1 = 16 * MiB;
constexpr size_t WS_WO1 = 22 * MiB;
constexpr size_t WS_WEGU = 24 * MiB;
constexpr size_t WS_WED = 136 * MiB;
constexpr size_t WS_WIN = 192 * MiB;
constexpr size_t WS_WUQ = WS_WIN + (size_t)NPROJ * D * 2;
constexpr size_t WS_WUKV = WS_WUQ + (size_t)768 * 384 * 2;
constexpr size_t WS_WO0 = WS_WUKV + (size_t)1024 * 256 * 2;
constexpr size_t WS_WGU = WS_WO0 + (size_t)D * D * 2;
constexpr size_t WS_WD = WS_WGU + (size_t)2 * DFF * D * 2;
static_assert(WS_WD + (size_t)D * DFF * 2 <= 218 * MiB, "L0 weights");
constexpr size_t WS_H = 218 * MiB;
constexpr size_t WS_QKVP = WS_H + (size_t)MT * D * 2;
constexpr size_t WS_CQKV = WS_QKVP + (size_t)MT * 1536 * 2;
constexpr size_t WS_Z = WS_CQKV + (size_t)MT * 768 * 2;
constexpr size_t WS_QKVC = WS_Z + (size_t)MT * 512 * 2;
constexpr size_t WS_GU = WS_QKVC + (size_t)MT * 1536 * 2;
constexpr size_t WS_GW = WS_GU + (size_t)2112 * 64 * 128 * 2;
constexpr size_t WS_GQK = WS_GW + (size_t)2112 * 64 * 128 * 2;
constexpr size_t WS_KN = WS_GQK + (size_t)2112 * 64 * 64 * 2;
constexpr size_t WS_VT = WS_KN + (size_t)MT * 512 * 2;
constexpr size_t WS_L0_END = WS_VT + (size_t)MT * 512 * 2;
constexpr size_t WS_MLAQ = WS_QKVP;
constexpr size_t WS_OFB = WS_MLAQ + (size_t)MT * 768 * 2;
static_assert(WS_OFB + (size_t)2 * MT * 512 * 2 <= WS_Z, "OFB overlay");
constexpr size_t WS_ACT = WS_QKVP;
constexpr size_t WS_XLB = 384 * MiB;
constexpr size_t WS_PART = WS_QKVC;
static_assert(WS_ACT + (size_t)MT * DFF * 2 <= WS_QKVC, "ACT overlay");
constexpr size_t WS_QK1 = WS_QKVP;
constexpr size_t WS_VT1 = WS_QK1 + (size_t)MT * 2048 * 2;
constexpr size_t WS_O1 = WS_VT1 + (size_t)MT * 1024 * 2;
constexpr size_t WS_F = 192 * MiB;
constexpr size_t WS_ACTS = 192 * MiB;
constexpr size_t WS_FS = WS_ACTS + (size_t)MOE_ROWS * DFE * 2;
constexpr size_t WS_PARTY = WS_FS + (size_t)MOE_ROWS * D * 2;
constexpr size_t WS_L1_END = WS_PARTY + (size_t)4 * 2048 * 1024 * 2;
constexpr size_t WS_END = (WS_L0_END > WS_L1_END ? WS_L0_END : WS_L1_END);
static_assert(WS_O1 + (size_t)ML * D * 2 <= WS_END && WS_END <= 541046912ull, "d_ws map must fit sum(inputs) bytes");

constexpr int CW_BAR = 4096;
constexpr int CW_ECNT = 8192;
constexpr int CW_QUEUE = 9216;
constexpr int CW_SCANDONE = 11264;
constexpr int CW_GOQ = 11328;
constexpr int CW_GDNQ = 10496;

constexpr int LDS_BYTES = 147456;
constexpr int MISC_OFF = LDS_BYTES - 512;

DI unsigned f2bf(float f) { unsigned u = __builtin_bit_cast(unsigned, f); return (u + 0x7fffu + ((u >> 16) & 1u)) >> 16; }
DI unsigned pk2(float lo, float hi) { return f2bf(lo) | (f2bf(hi) << 16); }
DI float bf2f(unsigned short b) { return __builtin_bit_cast(float, ((unsigned)b) << 16); }
DI float bflo(unsigned u) { return __builtin_bit_cast(float, u << 16); }
DI float bfhi(unsigned u) { return __builtin_bit_cast(float, u & 0xffff0000u); }
DI float wave_sum(float v) {
#pragma unroll
    for (int o = 1; o < 64; o <<= 1) v += __shfl_xor(v, o);
    return v;
}
DI float siluf(float x) { return x * __builtin_amdgcn_rcpf(1.f + __expf(-x)); }
DI float sigmoidf(float x) { return __builtin_amdgcn_rcpf(1.f + __expf(-x)); }
#define LDS_WAIT() asm volatile("s_waitcnt lgkmcnt(0)" ::: "memory")

#define XB_TMO      128
#define XB_XCNT(j)  (256  + 64 * (j))
#define XB_XSUB(j)  (1280 + 64 * (j))
#define XB_XGEN(j)  (2304 + 64 * (j))
#define XB_TOP      3328
#define XB_TOPGEN   3392
#define XCD_BAR_WORDS 3456
#define XB_SPIN_CAP (1u << 20)
DI unsigned xb_ld(unsigned* p)              { return __hip_atomic_load(p, __ATOMIC_RELAXED, __HIP_MEMORY_SCOPE_AGENT); }
DI unsigned xb_add(unsigned* p, unsigned v) { return __hip_atomic_fetch_add(p, v, __ATOMIC_RELAXED, __HIP_MEMORY_SCOPE_AGENT); }
DI unsigned xb_xcc_id() { return (unsigned)__builtin_amdgcn_s_getreg((3 << 11) | 20) & 0xFu; }
#define XB_SPIN(cond, bar) do { unsigned _sp = 0; while (cond) { __builtin_amdgcn_s_sleep(1); \
    if ((++_sp & 255u) == 0u) { if (xb_ld(&(bar)[XB_TMO])) break; if (_sp > XB_SPIN_CAP) { atomicAdd(&(bar)[XB_TMO], 1u); break; } } } } while (0)
struct XcdBarrier { unsigned* bar; unsigned x; volatile LAS unsigned* st; };
DI XcdBarrier xcd_barrier_post(unsigned* bar, volatile LAS unsigned* st) {
    XcdBarrier b; b.bar = bar; b.x = xb_xcc_id(); b.st = st;
    if (threadIdx.x == 0) (void)xb_add(&bar[XB_XCNT(b.x)], 1u);
    return b;
}
DI void xcd_barrier_complete(unsigned* bar, unsigned x, unsigned& nloc, unsigned& nx) {
    const unsigned G = gridDim.x * gridDim.y * gridDim.z;
    unsigned sum, cnt, mine, sp = 0u;
    for (;;) {
        sum = 0u; cnt = 0u; mine = 0u;
#pragma unroll
        for (unsigned j = 0; j < 16; ++j) { const unsigned c = xb_ld(&bar[XB_XCNT(j)]); sum += c; cnt += (c > 0u) ? 1u : 0u; mine = (j == x) ? c : mine; }
        if (sum == G) break;
        __builtin_amdgcn_s_sleep(1);
        if ((++sp & 255u) == 0u) { if (xb_ld(&bar[XB_TMO])) break; if (sp > XB_SPIN_CAP) { atomicAdd(&bar[XB_TMO], 1u); break; } }
    }
    nloc = mine > 0u ? mine : 1u; nx = cnt > 0u ? cnt : 1u;
}
DI void xcd_barrier(const XcdBarrier& b) {
    asm volatile("s_waitcnt vmcnt(0)" ::: "memory");
    __syncthreads();
    if (threadIdx.x == 0) {
        unsigned* bar = b.bar;
        __builtin_amdgcn_s_waitcnt(0);
        unsigned nloc = b.st[0], nx = b.st[1];
        if (nloc == 0u) { xcd_barrier_complete(bar, b.x, nloc, nx); b.st[0] = nloc; b.st[1] = nx; }
        const unsigned old = xb_add(&bar[XB_XSUB(b.x)], 1u);
        const unsigned gen = old / nloc;
        if (old + 1u == (gen + 1u) * nloc) {
            __builtin_amdgcn_fence(__ATOMIC_RELEASE, "agent");
            asm volatile("s_waitcnt vmcnt(0)" ::: "memory");
            const unsigned og = xb_add(&bar[XB_TOP], 1u);
            const unsigned tg = og / nx;
            if (og + 1u == (tg + 1u) * nx) xb_add(&bar[XB_TOPGEN], 1u);
            else XB_SPIN(xb_ld(&bar[XB_TOPGEN]) == tg, bar);
            __builtin_amdgcn_fence(__ATOMIC_ACQUIRE, "agent");
            xb_add(&bar[XB_XGEN(b.x)], 1u);
            asm volatile("s_waitcnt vmcnt(0)" ::: "memory");
        } else {
            XB_SPIN(xb_ld(&bar[XB_XGEN(b.x)]) == gen, bar);
            __builtin_amdgcn_fence(__ATOMIC_ACQUIRE, "agent");
            asm volatile("s_waitcnt vmcnt(0)" ::: "memory");
        }
    }
    __syncthreads();
}

namespace pg8 {
constexpr int BM = 256, BK = 64, HALF = 128, HTB = HALF * BK * 2, STAGE_BYTES = 8 * HTB, NXCD = 8, WGM = 8;
__host__ __device__ __forceinline__ int lds_byte(int r, int c) { const int st = (r >> 4) * 2 + (c >> 5), rr = r & 15, cc = c & 31, ob = rr * 64 + cc * 2; return st * 1024 + (ob ^ (((ob >> 9) & 1) << 5)); }
__host__ __device__ __forceinline__ void stage_rc(int b, int& R, int& C) { const int st = b / 1024, sb = b % 1024, swz = sb ^ (((sb >> 9) & 1) << 5); R = (st >> 1) * 16 + swz / 64; C = (st & 1) * 32 + (swz % 64) / 2; }
__host__ __device__ __forceinline__ int perm32(int rho) { const int n = rho >> 4, i = rho & 15; return 8 * (i >> 2) + 4 * n + (i & 3); }
struct Unit { int pm, pn, e, kb; };
struct Gemm { const bf16_t* A; const bf16_t* Bt; int lda, ldb, K; size_t bstride, astride; };
struct StaticOrder {
    int nM, nN, nwg, G, c;
    __device__ void init(int M, int N, int G_, int c_) { nM = M / BM; nN = N / BM; nwg = nM * nN; G = G_; c = c_; }
    __device__ bool next(int i, Unit& u) const {
        const long L = (long)i * G + c; if (L >= nwg) return false;
        int wgid = (int)L; { const int q = nwg / NXCD, r = nwg % NXCD, xcd = wgid % NXCD, off = wgid / NXCD; wgid = (xcd < r ? xcd * (q + 1) : r * (q + 1) + (xcd - r) * q) + off; }
        const int nig = WGM * nN, gid = wgid / nig, fm = gid * WGM, gsz = (nM - fm) < WGM ? (nM - fm) : WGM;
        u.pm = fm + ((wgid % nig) % gsz); u.pn = (wgid % nig) / gsz; u.e = 0; u.kb = 0; return true;
    }
};
struct MoeOrder : StaticOrder {
    int te[9];
    __device__ void init_moe(const unsigned* cnt, int N, int G_, int c_) {
        int t = 0;
#pragma unroll
        for (int e = 0; e < 8; ++e) { te[e] = t; t += (__builtin_amdgcn_readfirstlane((int)cnt[64 * e]) + 255) >> 8; }
        te[8] = t; nM = t; nN = N / BM; nwg = nM * nN; G = G_; c = c_;
    }
    __device__ bool next(int i, Unit& u) const {
        if (!StaticOrder::next(i, u)) return false;
        int e = 0;
#pragma unroll
        for (int k = 1; k < 8; ++k) e += (u.pm >= te[k]) ? 1 : 0;
        u.e = e; return true;
    }
};
struct SplitKOrder {
    int nsub, G, c;
    __device__ void init(int ks, int G_, int c_) { nsub = ks * 8; G = G_; c = c_; }
    __device__ bool next(int i, Unit& u) const { const int L = i * G + c; if (L >= nsub) return false; u.e = L >> 3; u.pm = (L >> 2) & 1; u.pn = L & 3; u.kb = 0; return true; }
};
struct MoeDownOrder : MoeOrder {
    int mt0, nfull;
    __device__ void init_down(const unsigned* cnt, int G_, int c_) {
        init_moe(cnt, 1024, G_, c_);
        const int units = nM * 4, R = units / G_;
        nfull = ((R * G_) & 3) == 0 ? R * G_ : units;
        mt0 = nfull >> 2;
    }
    __device__ int expert_of(int pm) const { int e = 0;
#pragma unroll
        for (int k = 1; k < 8; ++k) e += (pm >= te[k]) ? 1 : 0;
        return e; }
    __device__ bool next(int i, Unit& u) const { const int L = i * G + c; if (L >= nfull) return false; u.pm = L >> 2; u.pn = L & 3; u.e = expert_of(u.pm); u.kb = 0; return true; }
};
struct MoeTailOrder : MoeDownOrder {
    __device__ bool next(int i, Unit& u) const { const int L = i * G + c; if (L >= (nM - mt0) * 8) return false;
        u.pm = mt0 + (L >> 3); u.pn = (L >> 1) & 3; u.kb = (L & 1) * 1792; u.e = expert_of(u.pm); return true; }
};
DI unsigned cvt_pk_bf16(float lo, float hi) { unsigned r; asm volatile("v_cvt_pk_bf16_f32 %0, %1, %2" : "=v"(r) : "v"(lo), "v"(hi)); return r; }

typedef int i32x4 __attribute__((ext_vector_type(4)));
typedef int i32x8 __attribute__((ext_vector_type(8)));
DI i32x8 cat32(bf16x8 a, bf16x8 b) { return __builtin_shufflevector(__builtin_bit_cast(i32x4, a), __builtin_bit_cast(i32x4, b), 0, 1, 2, 3, 4, 5, 6, 7); }
template <bool FP8 = false, bool ALIGN = false, class Epi, class Sched>
DI void gemm_phase(LAS unsigned char* lds, const Gemm g, const Sched& S, const Epi& E) {
    int tid = threadIdx.x;
    asm volatile("" : "+v"(tid));
    const int wid = __builtin_amdgcn_readfirstlane(tid >> 6), lane = tid & 63, wr = wid >> 2, wc = wid & 3, fr = lane & 15, fq = lane >> 4;
    constexpr int ES = FP8 ? 1 : 2;
    const int K = g.K, nt = K * ES / 128;
    unsigned voffA[2], voffB[2];
#pragma unroll
    for (int i = 0; i < 2; ++i) { int R, C; stage_rc(tid * 16 + i * 8192, R, C); const int Rb = Epi::PERM ? ((R & ~31) + perm32(R & 31)) : R;
        voffA[i] = (unsigned)(R * g.lda * ES + C * 2); voffB[i] = (unsigned)(Rb * g.ldb * ES + C * 2); }
    const size_t kstep = (size_t)(BK * 2);
    const size_t hstepA = (size_t)HALF * g.lda * ES, hstepB = (size_t)HALF * g.ldb * ES;
    const size_t tstepA = 2 * hstepA, tstepB = 2 * hstepB;
    const unsigned ldsw = (unsigned)wid * 1024u;
    const int aoff = lds_byte(wr * 64 + fr, fq * 8), boff = lds_byte(wc * 32 + fr, fq * 8);
#define PG8_SA(b, h) (((b) * 2 + (h)) * HTB)
#define PG8_SB(b, h) ((4 + (b) * 2 + (h)) * HTB)
#define PG8_STAGE(bufoff, gbase, voff) do { _Pragma("unroll") for (int _i = 0; _i < 2; ++_i) \
        __builtin_amdgcn_global_load_lds((const unsigned*)((const char*)(gbase) + (voff)[_i]), (LAS unsigned*)(lds + (bufoff) + ldsw + _i * 8192), 16, 0, 0); } while (0)
#define PG8_LDA(dst, b, h) do { _Pragma("unroll") for (int m = 0; m < 4; ++m) { if constexpr (FP8) dst##8[m] = cat32(*(const LAS bf16x8*)(lds + PG8_SA(b, h) + aoff + m * 2048), *(const LAS bf16x8*)(lds + PG8_SA(b, h) + aoff + m * 2048 + 1024)); \
        else { _Pragma("unroll") for (int k = 0; k < 2; ++k) dst[m][k] = *(const LAS bf16x8*)(lds + PG8_SA(b, h) + aoff + m * 2048 + k * 1024); } } } while (0)
#define PG8_LDB(dst, b, h) do { _Pragma("unroll") for (int n = 0; n < 2; ++n) { if constexpr (FP8) dst##8[n] = cat32(*(const LAS bf16x8*)(lds + PG8_SB(b, h) + boff + n * 2048), *(const LAS bf16x8*)(lds + PG8_SB(b, h) + boff + n * 2048 + 1024)); \
        else { _Pragma("unroll") for (int k = 0; k < 2; ++k) dst[n][k] = *(const LAS bf16x8*)(lds + PG8_SB(b, h) + boff + n * 2048 + k * 1024); } } } while (0)
#define PG8_MMA(ai, bj, At, Bt) do { __builtin_amdgcn_s_setprio(1); _Pragma("unroll") for (int m = 0; m < 4; ++m) _Pragma("unroll") for (int n = 0; n < 2; ++n) { \
        if constexpr (FP8) asm volatile("v_mfma_f32_16x16x128_f8f6f4 %0, %1, %2, %0" : "+v"(acc[ai][bj][m][n]) : "v"(Bt##8[n]), "v"(At##8[m])); \
        else { _Pragma("unroll") for (int k = 0; k < 2; ++k) acc[ai][bj][m][n] = __builtin_amdgcn_mfma_f32_16x16x32_bf16(Bt[n][k], At[m][k], acc[ai][bj][m][n], 0, 0, 0); } } __builtin_amdgcn_s_setprio(0); } while (0)
#define PG8_WAIT_V(n) asm volatile("s_waitcnt vmcnt(" #n ")" ::: "memory")
#define PG8_WAIT_L(n) asm volatile("s_waitcnt lgkmcnt(" #n ")" ::: "memory")
#define PG8_BAR __builtin_amdgcn_s_barrier()
#define PG8_SCHED __builtin_amdgcn_sched_barrier(0)
    Unit cur, nxt; int ui = 0;
    if (!S.next(0, cur)) return;
    f32x4 acc[2][2][4][2];
#pragma unroll
    for (int a = 0; a < 2; ++a)
#pragma unroll
        for (int b = 0; b < 2; ++b)
#pragma unroll
            for (int m = 0; m < 4; ++m)
#pragma unroll
                for (int n = 0; n < 2; ++n) acc[a][b][m][n] = (f32x4){0.f, 0.f, 0.f, 0.f};
    bf16x8 At[4][2], B0[2][2], B1[2][2];
    i32x8 At8[4], B08[2], B18[2];
    const char* cA = (const char*)g.A + (size_t)cur.e * g.astride + (size_t)cur.pm * tstepA + cur.kb; const char* cB = (const char*)g.Bt + (size_t)cur.e * g.bstride + (size_t)cur.pn * tstepB + cur.kb;
    PG8_STAGE(PG8_SB(0, 0), cB, voffB); PG8_STAGE(PG8_SA(0, 0), cA, voffA); PG8_STAGE(PG8_SB(0, 1), cB + hstepB, voffB); PG8_STAGE(PG8_SA(0, 1), cA + hstepA, voffA);
    if (wr == 1) PG8_BAR;
    PG8_WAIT_V(4); PG8_BAR;
    PG8_STAGE(PG8_SB(1, 0), cB + kstep, voffB); PG8_STAGE(PG8_SA(1, 0), cA + kstep, voffA); PG8_STAGE(PG8_SB(1, 1), cB + hstepB + kstep, voffB);
    PG8_WAIT_V(6); PG8_BAR;
    for (;;) {
        const bool has_next = S.next(ui + 1, nxt);
        const char* nA = has_next ? (const char*)g.A + (size_t)nxt.e * g.astride + (size_t)nxt.pm * tstepA + nxt.kb : cA; const char* nB = has_next ? (const char*)g.Bt + (size_t)nxt.e * g.bstride + (size_t)nxt.pn * tstepB + nxt.kb : cB;
        for (int t = 0; t < nt; t += 2) {
            const bool last = (t == nt - 2);
            const char* a1 = cA + (size_t)(t + 1) * kstep;
            const char* a2 = last ? nA : cA + (size_t)(t + 2) * kstep; const char* b2 = last ? nB : cB + (size_t)(t + 2) * kstep;
            const char* a3 = a2 + kstep; const char* b3 = b2 + kstep;
            PG8_LDB(B0, 0, 0); PG8_SCHED; PG8_LDA(At, 0, 0); PG8_STAGE(PG8_SA(1, 1), a1 + hstepA, voffA);
            PG8_WAIT_L(8); PG8_BAR; PG8_WAIT_L(0); PG8_MMA(0, 0, At, B0); PG8_BAR; PG8_SCHED;
            PG8_LDB(B1, 0, 1); PG8_STAGE(PG8_SB(0, 0), b2, voffB);
            PG8_BAR; PG8_WAIT_L(0); PG8_MMA(0, 1, At, B1); PG8_BAR;
            PG8_LDA(At, 0, 1); PG8_STAGE(PG8_SA(0, 0), a2, voffA);
            PG8_BAR; PG8_WAIT_L(0); PG8_MMA(1, 0, At, B0); PG8_BAR; PG8_SCHED;
            PG8_STAGE(PG8_SB(0, 1), b2 + hstepB, voffB);
            PG8_WAIT_V(6); PG8_BAR; PG8_MMA(1, 1, At, B1); PG8_BAR;
            PG8_LDB(B0, 1, 0); PG8_SCHED; PG8_LDA(At, 1, 0); PG8_STAGE(PG8_SA(0, 1), a2 + hstepA, voffA);
            PG8_WAIT_L(8); PG8_BAR; PG8_WAIT_L(0); PG8_MMA(0, 0, At, B0); PG8_BAR; PG8_SCHED;
            PG8_LDB(B1, 1, 1); PG8_STAGE(PG8_SB(1, 0), b3, voffB);
            PG8_BAR; PG8_WAIT_L(0); PG8_MMA(0, 1, At, B1); PG8_BAR;
            PG8_LDA(At, 1, 1); PG8_STAGE(PG8_SA(1, 0), a3, voffA);
            PG8_BAR; PG8_WAIT_L(0); PG8_MMA(1, 0, At, B0); PG8_BAR; PG8_SCHED;
            PG8_STAGE(PG8_SB(1, 1), b3 + hstepB, voffB);
            PG8_WAIT_V(6); PG8_BAR; PG8_MMA(1, 1, At, B1); PG8_BAR;
        }
        if constexpr (ALIGN) if (wr == 0) PG8_BAR;
        if constexpr (FP8) asm volatile("s_nop 15\n\ts_nop 15" ::: "memory");
        E(acc, cur, wr, wc, fr, fq);
        if (!has_next) break;
#pragma unroll
        for (int a = 0; a < 2; ++a)
#pragma unroll
            for (int b = 0; b < 2; ++b)
#pragma unroll
                for (int m = 0; m < 4; ++m)
#pragma unroll
                    for (int n = 0; n < 2; ++n) acc[a][b][m][n] = (f32x4){0.f, 0.f, 0.f, 0.f};
        cur = nxt; cA = nA; cB = nB; ++ui;
        if constexpr (ALIGN) if (wr == 1) PG8_BAR;
    }
    PG8_WAIT_V(0);
    if constexpr (!ALIGN) if (wr == 0) PG8_BAR;
    PG8_BAR;
#undef PG8_SA
#undef PG8_SB
#undef PG8_STAGE
#undef PG8_LDA
#undef PG8_LDB
#undef PG8_MMA
#undef PG8_WAIT_V
#undef PG8_WAIT_L
#undef PG8_BAR
#undef PG8_SCHED
}

struct EpiBf16 {
    static constexpr bool PERM = true;
    bf16_t* O; int ldc;
    DI void operator()(const f32x4 (&acc)[2][2][4][2], const Unit& u, int wr, int wc, int fr, int fq) const {
        const int row0 = u.pm * BM + wr * 64 + fr, col0 = u.pn * BM + wc * 32 + 8 * fq;
#pragma unroll
        for (int ai = 0; ai < 2; ++ai)
#pragma unroll
            for (int m = 0; m < 4; ++m) { bf16_t* rowp = O + (size_t)(row0 + ai * HALF + m * 16) * ldc + col0;
#pragma unroll
                for (int bj = 0; bj < 2; ++bj) { const f32x4 v0 = acc[ai][bj][m][0], v1 = acc[ai][bj][m][1];
                    u32x4 w; w.x = cvt_pk_bf16(v0[0], v0[1]); w.y = cvt_pk_bf16(v0[2], v0[3]); w.z = cvt_pk_bf16(v1[0], v1[1]); w.w = cvt_pk_bf16(v1[2], v1[3]);
                    *(u32x4*)(rowp + bj * HALF) = w; } }
    }
};
struct EpiWin {
    static constexpr bool PERM = true;
    bf16_t* QKVP; bf16_t* Z; bf16_t* CQKV; float* AB;
    DI void operator()(const f32x4 (&acc)[2][2][4][2], const Unit& u, int wr, int wc, int fr, int fq) const {
        bf16_t* base; int ldc, pn;
        if (u.pn < 6) { base = QKVP; ldc = 1536; pn = u.pn; } else if (u.pn < 8) { base = Z; ldc = 512; pn = u.pn - 6; } else { base = CQKV; ldc = 768; pn = u.pn - 8; }
        const int row0 = u.pm * BM + wr * 64 + fr, col0 = pn * BM + wc * 32 + 8 * fq;
#pragma unroll
        for (int ai = 0; ai < 2; ++ai)
#pragma unroll
            for (int m = 0; m < 4; ++m) { const int row = row0 + ai * HALF + m * 16; bf16_t* rowp = base + (size_t)row * ldc + col0;
#pragma unroll
                for (int bj = 0; bj < 2; ++bj) { const f32x4 v0 = acc[ai][bj][m][0], v1 = acc[ai][bj][m][1];
                    u32x4 w; w.x = cvt_pk_bf16(v0[0], v0[1]); w.y = cvt_pk_bf16(v0[2], v0[3]); w.z = cvt_pk_bf16(v1[0], v1[1]); w.w = cvt_pk_bf16(v1[2], v1[3]);
                    *(u32x4*)(rowp + bj * HALF) = w; }
                if (u.pn == 10 && wc == 1 && fq < 2) { float* ab = AB + (size_t)row * 16 + 8 * fq; *(f32x4*)ab = acc[ai][1][m][0]; *(f32x4*)(ab + 4) = acc[ai][1][m][1]; }
            }
    }
};
struct EpiResid {
    static constexpr bool PERM = false;
    const float* baseL; float* outL; const float* baseC; float* outC; const float* gate;
    DI void operator()(const f32x4 (&acc)[2][2][4][2], const Unit& u, int wr, int wc, int fr, int fq) const {
        const float* bs; float* os; int r, pm;
        if (u.pm < 64) { bs = baseL; os = outL; r = u.pm >> 5; pm = u.pm; } else { bs = baseC; os = outC; r = 2; pm = u.pm - 64; }
        const float* gv = gate + (size_t)r * 6144;
        const int row0 = pm * BM + wr * 64 + fr, col0 = u.pn * BM + wc * 32 + 4 * fq;
        f32x4 gg[2][2];
#pragma unroll
        for (int bj = 0; bj < 2; ++bj)
#pragma unroll
            for (int n = 0; n < 2; ++n) gg[bj][n] = *(const f32x4*)(gv + col0 + bj * HALF + n * 16);
#pragma unroll
        for (int ai = 0; ai < 2; ++ai)
#pragma unroll
            for (int m = 0; m < 4; ++m) { const size_t ro = (size_t)(row0 + ai * HALF + m * 16) * D + col0;
#pragma unroll
                for (int bj = 0; bj < 2; ++bj)
#pragma unroll
                    for (int n = 0; n < 2; ++n) { const f32x4 b = *(const f32x4*)(bs + ro + bj * HALF + n * 16);
                        *(f32x4*)(os + ro + bj * HALF + n * 16) = b + gg[bj][n] * acc[ai][bj][m][n]; } }
    }
};
DI unsigned cvt4_fp8(float a, float b, float c, float d) {
    a = fminf(fmaxf(a, -448.f), 448.f); b = fminf(fmaxf(b, -448.f), 448.f); c = fminf(fmaxf(c, -448.f), 448.f); d = fminf(fmaxf(d, -448.f), 448.f);
    unsigned r = 0; r = __builtin_amdgcn_cvt_pk_fp8_f32(a, b, r, false); r = __builtin_amdgcn_cvt_pk_fp8_f32(c, d, r, true); return r;
}
struct EpiSwigluF8 {
    static constexpr bool PERM = true;
    unsigned char* O; int ldc; float inscale, outscale;
    DI void operator()(const f32x4 (&acc)[2][2][4][2], const Unit& u, int wr, int wc, int fr, int fq) const {
        asm volatile("" : "+v"(fr), "+v"(fq));
        const int row0 = u.pm * BM + wr * 64 + fr, col0 = u.pn * HALF + wc * 32 + 8 * fq;
        const float k1 = -inscale * 1.4426950408889634f, iC = 1.f / (inscale * inscale * outscale);
#pragma unroll
        for (int ai = 0; ai < 2; ++ai)
#pragma unroll
            for (int m = 0; m < 4; ++m) { unsigned char* rowp = O + (size_t)(row0 + ai * HALF + m * 16) * ldc + col0;
                float o[8];
#pragma unroll
                for (int n = 0; n < 2; ++n) { const f32x4 ag = acc[ai][0][m][n], au = acc[ai][1][m][n];
#pragma unroll
                    for (int j = 0; j < 4; ++j) { const float e = __builtin_amdgcn_exp2f(ag[j] * k1);
                        o[4 * n + j] = ag[j] * __builtin_amdgcn_rcpf(__builtin_fmaf(e, iC, iC)) * au[j]; } }
                u32x2 w; w.x = cvt4_fp8(o[0], o[1], o[2], o[3]); w.y = cvt4_fp8(o[4], o[5], o[6], o[7]);
                *(u32x2*)rowp = w; }
    }
};
struct EpiBf16S {
    static constexpr bool PERM = true;
    bf16_t* O; int ldc; float scale;
    DI void operator()(const f32x4 (&acc)[2][2][4][2], const Unit& u, int wr, int wc, int fr, int fq) const {
        asm volatile("" : "+v"(fr), "+v"(fq));
        const int row0 = u.pm * BM + wr * 64 + fr, col0 = u.pn * BM + wc * 32 + 8 * fq;
#pragma unroll
        for (int ai = 0; ai < 2; ++ai)
#pragma unroll
            for (int m = 0; m < 4; ++m) { bf16_t* rowp = O + (size_t)(row0 + ai * HALF + m * 16) * ldc + col0;
#pragma unroll
                for (int bj = 0; bj < 2; ++bj) { const f32x4 v0 = acc[ai][bj][m][0] * scale, v1 = acc[ai][bj][m][1] * scale;
                    u32x4 w; w.x = cvt_pk_bf16(v0[0], v0[1]); w.y = cvt_pk_bf16(v0[2], v0[3]); w.z = cvt_pk_bf16(v1[0], v1[1]); w.w = cvt_pk_bf16(v1[2], v1[3]);
                    *(u32x4*)(rowp + bj * HALF) = w; } }
    }
};
struct EpiMoeTail {
    static constexpr bool PERM = true;
    bf16_t* P; int row0; float scale;
    DI void operator()(const f32x4 (&acc)[2][2][4][2], const Unit& u, int wr, int wc, int fr, int fq) const {
        asm volatile("" : "+v"(fr), "+v"(fq));
        bf16_t* O = P + (size_t)(u.kb / 1792) * (2048 * 1024);
        const int row_ = u.pm * BM - row0 + wr * 64 + fr, col0 = u.pn * BM + wc * 32 + 8 * fq;
#pragma unroll
        for (int ai = 0; ai < 2; ++ai)
#pragma unroll
            for (int m = 0; m < 4; ++m) { bf16_t* rowp = O + (size_t)(row_ + ai * HALF + m * 16) * D + col0;
#pragma unroll
                for (int bj = 0; bj < 2; ++bj) { const f32x4 v0 = acc[ai][bj][m][0] * scale, v1 = acc[ai][bj][m][1] * scale;
                    u32x4 w; w.x = cvt_pk_bf16(v0[0], v0[1]); w.y = cvt_pk_bf16(v0[2], v0[3]); w.z = cvt_pk_bf16(v1[0], v1[1]); w.w = cvt_pk_bf16(v1[2], v1[3]);
                    *(u32x4*)(rowp + bj * HALF) = w; } }
    }
};
struct EpiPartial {
    static constexpr bool PERM = false;
    float* P; float scale;
    DI void operator()(const f32x4 (&acc)[2][2][4][2], const Unit& u, int wr, int wc, int fr, int fq) const {
        float* base = P + (size_t)u.e * (512 * 1024);
        const int row0 = u.pm * BM + wr * 64 + fr, col0 = u.pn * BM + wc * 32 + 4 * fq;
#pragma unroll
        for (int ai = 0; ai < 2; ++ai)
#pragma unroll
            for (int m = 0; m < 4; ++m) { const size_t ro = (size_t)(row0 + ai * HALF + m * 16) * D + col0;
#pragma unroll
                for (int bj = 0; bj < 2; ++bj)
#pragma unroll
                    for (int n = 0; n < 2; ++n) *(f32x4*)(base + ro + bj * HALF + n * 16) = acc[ai][bj][m][n] * scale; }
    }
};
template <bool BASE_F32>
struct EpiResidB {
    static constexpr bool PERM = true;
    const void* base; bf16_t* out; const float* gate; float scale;
    DI void operator()(const f32x4 (&acc)[2][2][4][2], const Unit& u, int wr, int wc, int fr, int fq) const {
        const float* gv = gate + (size_t)(u.pm >> 5) * 6144;
        const int row0 = u.pm * BM + wr * 64 + fr, col0 = u.pn * BM + wc * 32 + 8 * fq;
        f32x4 gg[2][2];
#pragma unroll
        for (int bj = 0; bj < 2; ++bj)
#pragma unroll
            for (int n = 0; n < 2; ++n) gg[bj][n] = *(const f32x4*)(gv + col0 + bj * HALF + 4 * n) * scale;
        constexpr int MB = 4;
#pragma unroll
        for (int ai = 0; ai < 2; ++ai)
#pragma unroll
            for (int mb = 0; mb < 4; mb += MB) {
                f32x4 b0[MB][2], b1[MB][2];
#pragma unroll
                for (int mm = 0; mm < MB; ++mm) { const size_t ro = (size_t)(row0 + ai * HALF + (mb + mm) * 16) * D + col0;
#pragma unroll
                    for (int bj = 0; bj < 2; ++bj) {
                        if constexpr (BASE_F32) { b0[mm][bj] = __builtin_nontemporal_load((const f32x4*)((const float*)base + ro + bj * HALF)); b1[mm][bj] = __builtin_nontemporal_load((const f32x4*)((const float*)base + ro + bj * HALF + 4)); }
                        else { const u32x4 rb = *(const u32x4*)((const bf16_t*)base + ro + bj * HALF);
                            b0[mm][bj] = (f32x4){bflo(rb.x), bfhi(rb.x), bflo(rb.y), bfhi(rb.y)}; b1[mm][bj] = (f32x4){bflo(rb.z), bfhi(rb.z), bflo(rb.w), bfhi(rb.w)}; } } }
#pragma unroll
                for (int mm = 0; mm < MB; ++mm) { const int m = mb + mm; const size_t ro = (size_t)(row0 + ai * HALF + m * 16) * D + col0;
#pragma unroll
                    for (int bj = 0; bj < 2; ++bj) {
                        const f32x4 v0 = b0[mm][bj] + gg[bj][0] * acc[ai][bj][m][0], v1 = b1[mm][bj] + gg[bj][1] * acc[ai][bj][m][1];
                        u32x4 w; w.x = cvt_pk_bf16(v0[0], v0[1]); w.y = cvt_pk_bf16(v0[2], v0[3]); w.z = cvt_pk_bf16(v1[0], v1[1]); w.w = cvt_pk_bf16(v1[2], v1[3]);
                        *(u32x4*)(out + ro + bj * HALF) = w; } }
            }
    }
};
struct EpiSwiglu {
    static constexpr bool PERM = true;
    bf16_t* O; int ldc;
    DI void operator()(const f32x4 (&acc)[2][2][4][2], const Unit& u, int wr, int wc, int fr, int fq) const {
        const int row0 = u.pm * BM + wr * 64 + fr, col0 = u.pn * HALF + wc * 32 + 8 * fq;
#pragma unroll
        for (int ai = 0; ai < 2; ++ai)
#pragma unroll
            for (int m = 0; m < 4; ++m) { bf16_t* rowp = O + (size_t)(row0 + ai * HALF + m * 16) * ldc + col0;
                float o[8];
#pragma unroll
                for (int n = 0; n < 2; ++n) { const f32x4 gt = acc[ai][0][m][n], up = acc[ai][1][m][n];
#pragma unroll
                    for (int j = 0; j < 4; ++j) { const float e = __builtin_amdgcn_exp2f(-gt[j]);
                        o[4 * n + j] = gt[j] * up[j] * __builtin_amdgcn_rcpf(__builtin_fmaf(e, 1.4426950408889634f, 1.4426950408889634f)); } }
                u32x4 w; w.x = cvt_pk_bf16(o[0], o[1]); w.y = cvt_pk_bf16(o[2], o[3]); w.z = cvt_pk_bf16(o[4], o[5]); w.w = cvt_pk_bf16(o[6], o[7]);
                *(u32x4*)rowp = w; }
    }
};
struct EpiSwigluQ8 {
    static constexpr bool PERM = true;
    unsigned char* O; int ldc;
    DI void operator()(const f32x4 (&acc)[2][2][4][2], const Unit& u, int wr, int wc, int fr, int fq) const {
        const int row0 = u.pm * BM + wr * 64 + fr, col0 = u.pn * HALF + wc * 32 + 8 * fq;
#pragma unroll
        for (int ai = 0; ai < 2; ++ai)
#pragma unroll
            for (int m = 0; m < 4; ++m) { unsigned char* rowp = O + (size_t)(row0 + ai * HALF + m * 16) * ldc + col0;
                float o[8];
#pragma unroll
                for (int n = 0; n < 2; ++n) { const f32x4 gt = acc[ai][0][m][n], up = acc[ai][1][m][n];
#pragma unroll
                    for (int j = 0; j < 4; ++j) { const float e = __builtin_amdgcn_exp2f(-gt[j]);
                        o[4 * n + j] = gt[j] * up[j] * __builtin_amdgcn_rcpf(__builtin_fmaf(e, 1.4426950408889634f / 8.f, 1.4426950408889634f / 8.f)); } }
                u32x2 w; w.x = cvt4_fp8(o[0], o[1], o[2], o[3]); w.y = cvt4_fp8(o[4], o[5], o[6], o[7]);
                *(u32x2*)rowp = w; }
    }
};
}

typedef __bf16 bf2_t __attribute__((ext_vector_type(2)));
typedef float f2_t __attribute__((ext_vector_type(2)));
DI unsigned cvtpk(float lo, float hi) { f2_t v = {lo, hi}; return __builtin_bit_cast(unsigned, __builtin_convertvector(v, bf2_t)); }
#define MFMA32(a, b, c) __builtin_amdgcn_mfma_f32_32x32x16_bf16((a), (b), (c), 0, 0, 0)
DI int crow(int reg, int h) { return (reg & 3) + 8 * (reg >> 2) + 4 * h; }

struct Frame {
    LAS unsigned char* lds;
    volatile LAS unsigned* MISC;
    unsigned* ctl;
    unsigned char* ws;
    int tid, lane, wave, G, bid;
    const float* const* in;
    float* out;
};

constexpr int VROW = 136;
constexpr float LOG2E = 1.4426950408889634f;
constexpr float NEG_BIG = -1.0e30f;
constexpr float ATT_THR = 8.f;

template <int NS, int KROWB>
DI void attn_scores(const LAS unsigned char* Ks, int r, int h, const bf16x8 (&qf)[NS], f32x16 (&x)[2], const f32x16& nin) {
    bf16x8 kf[2][NS];
#pragma unroll
    for (int kb = 0; kb < 2; ++kb)
#pragma unroll
        for (int s = 0; s < NS; ++s) kf[kb][s] = *(const LAS bf16x8*)(Ks + (32 * kb + r) * KROWB + (16 * s + 8 * h) * 2);
    __builtin_amdgcn_sched_barrier(0);
#pragma unroll
    for (int kb = 0; kb < 2; ++kb) {
        x[kb] = MFMA32(kf[kb][0], qf[0], nin);
#pragma unroll
        for (int s = 1; s < NS; ++s) x[kb] = MFMA32(kf[kb][s], qf[s], x[kb]);
    }
}
DI float attn_mref(float m) { return m < -1.0e29f ? 0.f : m; }
DI void attn_softmax_pv(f32x16 (&x)[2], f32x16& nin, float& m, f32x16& ls, f32x16 (&o)[2], const LAS unsigned char* Vs, int r, int h) {
    const float mr = -nin[0];
    s16x4 vlo[2][2][2], vhi[2][2][2];
#pragma unroll
    for (int kb = 0; kb < 2; ++kb)
#pragma unroll
        for (int s2 = 0; s2 < 2; ++s2)
#pragma unroll
            for (int db = 0; db < 2; ++db) {
                const LAS unsigned char* vp = Vs + (32 * db + r) * VROW + (32 * kb + 16 * s2 + 4 * h) * 2;
                vlo[kb][s2][db] = *(const LAS s16x4*)vp; vhi[kb][s2][db] = *(const LAS s16x4*)(vp + 16);
            }
    __builtin_amdgcn_sched_barrier(0);
    float mt = fmaxf(fmaxf(x[0][0], x[0][1]), x[0][2]);
#pragma unroll
    for (int i = 3; i < 15; i += 2) mt = fmaxf(fmaxf(mt, x[0][i]), x[0][i + 1]);
    mt = fmaxf(mt, x[0][15]);
#pragma unroll
    for (int i = 0; i < 16; i += 2) mt = fmaxf(fmaxf(mt, x[1][i]), x[1][i + 1]);
    { const auto sw_ = __builtin_amdgcn_permlane32_swap(__builtin_bit_cast(unsigned, mt), __builtin_bit_cast(unsigned, mt), false, false);
      mt = fmaxf(__builtin_bit_cast(float, sw_[0]), __builtin_bit_cast(float, sw_[1])); }
    const float mnew = fmaxf(m, mr + mt);
    const float shift = mnew - mr;
    if (__any(shift > ATT_THR || m < -1.0e29f)) {
        const float alpha = __builtin_amdgcn_exp2f(m - mnew);
#pragma unroll
        for (int i = 0; i < 16; ++i) ls[i] *= alpha;
#pragma unroll
        for (int db = 0; db < 2; ++db)
#pragma unroll
            for (int i = 0; i < 16; ++i) o[db][i] *= alpha;
#pragma unroll
        for (int kb = 0; kb < 2; ++kb)
#pragma unroll
            for (int i = 0; i < 16; ++i) x[kb][i] -= shift;
        m = mnew;
        const float nv = -attn_mref(mnew);
#pragma unroll
        for (int i = 0; i < 16; ++i) asm volatile("v_mov_b32 %0, %1" : "+v"(nin[i]) : "v"(nv));
    }
#pragma unroll
    for (int kb = 0; kb < 2; ++kb)
#pragma unroll
        for (int i = 0; i < 16; ++i) x[kb][i] = __builtin_amdgcn_exp2f(x[kb][i]);
    const bf16x8 ones = {(short)0x3F80, (short)0x3F80, (short)0x3F80, (short)0x3F80, (short)0x3F80, (short)0x3F80, (short)0x3F80, (short)0x3F80};
#pragma unroll
    for (int kb = 0; kb < 2; ++kb)
#pragma unroll
        for (int s2 = 0; s2 < 2; ++s2) {
            u32x4 pp;
            pp.x = cvtpk(x[kb][8 * s2 + 0], x[kb][8 * s2 + 1]); pp.y = cvtpk(x[kb][8 * s2 + 2], x[kb][8 * s2 + 3]);
            pp.z = cvtpk(x[kb][8 * s2 + 4], x[kb][8 * s2 + 5]); pp.w = cvtpk(x[kb][8 * s2 + 6], x[kb][8 * s2 + 7]);
            const bf16x8 pf = __builtin_bit_cast(bf16x8, pp);
#pragma unroll
            for (int db = 0; db < 2; ++db) {
                const bf16x8 vf = __builtin_shufflevector(vlo[kb][s2][db], vhi[kb][s2][db], 0, 1, 2, 3, 4, 5, 6, 7);
                o[db] = MFMA32(vf, pf, o[db]);
            }
            ls = MFMA32(ones, pf, ls);
        }
}
DI void attn_store(const f32x16 (&o)[2], float l, bf16_t* orow, int h) {
    const float inv = 1.f / l;
#pragma unroll
    for (int db = 0; db < 2; ++db)
#pragma unroll
        for (int g = 0; g < 4; ++g) {
            u32x2 w; w.x = cvtpk(o[db][4 * g] * inv, o[db][4 * g + 1] * inv); w.y = cvtpk(o[db][4 * g + 2] * inv, o[db][4 * g + 3] * inv);
            *(u32x2*)(orow + 32 * db + 8 * g + 4 * h) = w;
        }
}

DI void attn_store_f8(const f32x16 (&o)[2], float l, unsigned char* orow, int h) {
    const float inv = 8.f / l;
#pragma unroll
    for (int db = 0; db < 2; ++db)
#pragma unroll
        for (int g = 0; g < 4; ++g)
            *(unsigned*)(orow + 32 * db + 8 * g + 4 * h) = pg8::cvt4_fp8(o[db][4 * g] * inv, o[db][4 * g + 1] * inv, o[db][4 * g + 2] * inv, o[db][4 * g + 3] * inv);
}
constexpr int MLA_KROWB = 208, MLA_TILE = 64 * MLA_KROWB + 64 * VROW;
DI void mla_unit(Frame& F, int b, int head, int qb) {
    const bf16_t* MLAQ = (const bf16_t*)(F.ws + WS_MLAQ); const bf16_t* KN = (const bf16_t*)(F.ws + WS_KN);
    const bf16_t* KR = (const bf16_t*)(F.ws + WS_KR); const bf16_t* VT = (const bf16_t*)(F.ws + WS_VT);
    const float* ROPE = (const float*)(F.ws + WS_ROPE);
    bf16_t* MIX = (bf16_t*)(F.ws + WS_H);
    int tid_ = F.tid, lane_ = F.lane;
    asm volatile("" : "+v"(tid_), "+v"(lane_));
    const int r = lane_ & 31, h = lane_ >> 5;
    const int g = F.wave >> 2, wq = F.wave & 3;
    const bool lat = qb >= 0;
    const int t = lat ? qb * 128 + wq * 32 + r : 0;
    const int qrow = lat ? b * SEQ + t : ML + b * LC + (-1 - qb) * 128 + wq * 32 + r;
    const float qs = 0.10206207261596577f * LOG2E;
    bf16x8 qf[6];
    {
        const bf16_t* qp = MLAQ + (size_t)qrow * 768 + head * 96;
#pragma unroll
        for (int s = 0; s < 6; ++s) {
            const u32x4 raw = *(const u32x4*)(qp + 16 * s + 8 * h);
            float v[8];
            v[0] = bflo(raw.x); v[1] = bfhi(raw.x); v[2] = bflo(raw.y); v[3] = bfhi(raw.y); v[4] = bflo(raw.z); v[5] = bfhi(raw.z); v[6] = bflo(raw.w); v[7] = bfhi(raw.w);
            if (s >= 4 && lat) {
                const int i0 = 8 * (s - 4) + 4 * h;
                const f32x4 cs = *(const f32x4*)(ROPE + (size_t)t * 16 + i0), sn = *(const f32x4*)(ROPE + (size_t)SEQ * 16 + (size_t)t * 16 + i0);
#pragma unroll
                for (int p = 0; p < 4; ++p) { const float a = v[2 * p], bb = v[2 * p + 1]; v[2 * p] = a * cs[p] - bb * sn[p]; v[2 * p + 1] = bb * cs[p] + a * sn[p]; }
            }
            u32x4 pk; pk.x = cvtpk(v[0] * qs, v[1] * qs); pk.y = cvtpk(v[2] * qs, v[3] * qs); pk.z = cvtpk(v[4] * qs, v[5] * qs); pk.w = cvtpk(v[6] * qs, v[7] * qs);
            qf[s] = __builtin_bit_cast(bf16x8, pk);
        }
    }
    float m = NEG_BIG;
    f32x16 o[2], ls, nin;
#pragma unroll
    for (int i = 0; i < 16; ++i) { ls[i] = 0.f; nin[i] = -0.f; }
#pragma unroll
    for (int db = 0; db < 2; ++db)
#pragma unroll
        for (int i = 0; i < 16; ++i) o[db][i] = 0.f;
    const int npair = lat ? 66 : 2;
    unsigned koff[3], krb[3], kdst[3], voff[2], vdst[2];
#pragma unroll
    for (int j = 0; j < 3; ++j) { const int id = tid_ + 512 * j, sl = id / 768, rem = id - sl * 768, row = rem / 12, ch = rem - row * 12;
        const int rl = b * SEQ + 64 * sl + row;
        if (ch < 8) { koff[j] = (unsigned)(WS_KN + ((size_t)rl * 512 + head * 64 + ch * 8) * 2); krb[j] = 1024u; }
        else { koff[j] = (unsigned)(WS_KR + ((size_t)rl * 32 + (ch - 8) * 8) * 2); krb[j] = 64u; }
        kdst[j] = sl * MLA_TILE + row * MLA_KROWB + ch * 16; }
#pragma unroll
    for (int j = 0; j < 2; ++j) { const int id = tid_ + 512 * j, sl = id >> 9, dvr = (id & 511) >> 3, ch = id & 7;
        voff[j] = (unsigned)(WS_VT + ((size_t)(head * 64 + dvr) * MT + b * SEQ + 64 * sl + ch * 8) * 2);
        vdst[j] = sl * MLA_TILE + 64 * MLA_KROWB + dvr * VROW + ch * 16; }
    const int ctx0 = ML + b * LC - b * SEQ;
    u32x4 rk[3], rv[2];
#define MLA_LOAD(ip) do { const unsigned kr_ = (unsigned)((ip) < 2 ? ctx0 + 128 * (ip) : 128 * ((ip) - 2)); \
        _Pragma("unroll") for (int j = 0; j < 3; ++j) rk[j] = *(const u32x4*)(F.ws + (koff[j] + kr_ * krb[j])); \
        _Pragma("unroll") for (int j = 0; j < 2; ++j) rv[j] = *(const u32x4*)(F.ws + (voff[j] + kr_ * 2u)); } while (0)
#define MLA_STORE(st) do { LAS unsigned char* sb = F.lds + (st) * 2 * MLA_TILE; \
        _Pragma("unroll") for (int j = 0; j < 3; ++j) *(LAS u32x4*)(sb + kdst[j]) = rk[j]; \
        _Pragma("unroll") for (int j = 0; j < 2; ++j) { LAS unsigned char* d_ = sb + vdst[j]; *(LAS u32x2*)d_ = (u32x2){rv[j].x, rv[j].y}; *(LAS u32x2*)(d_ + 8) = (u32x2){rv[j].z, rv[j].w}; } } while (0)
    __syncthreads();
    MLA_LOAD(0); MLA_STORE(0);
    if (npair > 1) MLA_LOAD(1);
    __syncthreads();
    for (int ip = 0; ip < npair; ++ip) {
        if (ip + 1 < npair) MLA_STORE((ip + 1) & 1);
        if (ip + 2 < npair) MLA_LOAD(ip + 2);
        const LAS unsigned char* Ks = F.lds + ((ip & 1) * 2 + g) * MLA_TILE;
        f32x16 x[2];
        attn_scores<6, MLA_KROWB>(Ks, r, h, qf, x, nin);
        attn_softmax_pv(x, nin, m, ls, o, Ks + 64 * MLA_KROWB, r, h);
        __syncthreads();
    }
#undef MLA_LOAD
#undef MLA_STORE
    LAS float* cmb = (LAS float*)F.lds;
    if (g == 1) {
        LAS float* cw = cmb + wq * 34 * 64 + F.lane;
#pragma unroll
        for (int db = 0; db < 2; ++db)
#pragma unroll
            for (int i = 0; i < 16; ++i) cw[(db * 16 + i) * 64] = o[db][i];
        cw[32 * 64] = attn_mref(m); cw[33 * 64] = ls[0];
    }
    __syncthreads();
    if (g == 0) {
        const LAS float* cw = cmb + wq * 34 * 64 + F.lane;
        const float m1 = cw[32 * 64], l1 = cw[33 * 64];
        m = attn_mref(m);
        const float mt = fmaxf(m, m1);
        const float a0 = __builtin_amdgcn_exp2f(m - mt), a1 = __builtin_amdgcn_exp2f(m1 - mt);
        const float l = ls[0] * a0 + l1 * a1;
#pragma unroll
        for (int db = 0; db < 2; ++db)
#pragma unroll
            for (int i = 0; i < 16; ++i) o[db][i] = o[db][i] * a0 + cw[(db * 16 + i) * 64] * a1;
        attn_store(o, l, MIX + (size_t)qrow * D + 512 + head * 64, h);
    }
}

constexpr int NA_KROWB = 144, NA_TILE = 64 * NA_KROWB + 64 * VROW;
DI void na_unit(Frame& F, int b, int head, int rg) {
    LAS float* rpbs = (LAS float*)(F.lds + 4 * NA_TILE);
    const bf16_t* QK1 = (const bf16_t*)(F.ws + WS_QK1); const bf16_t* VT1 = (const bf16_t*)(F.ws + WS_VT1);
    bf16_t* O1 = (bf16_t*)(F.ws + WS_O1);
    const float* rpb = F.in[21] + head * 465;
    const int r = F.lane & 31, h = F.lane >> 5;
    const int rq = 4 * rg + (F.wave >> 1), cq = 32 * (F.wave & 1) + r;
    const int qrow = b * SEQ + rq * 64 + cq;
    const int r0q = min(max(rq - 4, 0), 120);
    const int c0 = min(max(cq - 8, 0), 48);
    const float qs = 0.125f * LOG2E;
    __syncthreads();
    for (int i = F.tid; i < 465; i += 512) rpbs[i] = rpb[i] * LOG2E;
    bf16x8 qf[4];
    {
        const bf16_t* qp = QK1 + (size_t)qrow * 2048 + head * 64;
#pragma unroll
        for (int s = 0; s < 4; ++s) {
            const u32x4 raw = *(const u32x4*)(qp + 16 * s + 8 * h);
            u32x4 pk; pk.x = cvtpk(bflo(raw.x) * qs, bfhi(raw.x) * qs); pk.y = cvtpk(bflo(raw.y) * qs, bfhi(raw.y) * qs);
            pk.z = cvtpk(bflo(raw.z) * qs, bfhi(raw.z) * qs); pk.w = cvtpk(bflo(raw.w) * qs, bfhi(raw.w) * qs);
            qf[s] = __builtin_bit_cast(bf16x8, pk);
        }
    }
    float m = NEG_BIG;
    f32x16 o[2], ls, nin;
#pragma unroll
    for (int i = 0; i < 16; ++i) { ls[i] = 0.f; nin[i] = -0.f; }
#pragma unroll
    for (int db = 0; db < 2; ++db)
#pragma unroll
        for (int i = 0; i < 16; ++i) o[db][i] = 0.f;
    const int kr_lo = min(max(4 * rg - 4, 0), 120), kr_hi = min(max(4 * rg - 1, 0), 120) + 7;
    const int nnb = kr_hi - kr_lo + 1, ntile = nnb + 4, npair = (ntile + 1) >> 1;
    const int krr = F.tid >> 3, kch = F.tid & 7;
    u32x4 rk[2], rv[2];
#define NA_TILE_OF(p) ((nnb == 11 && (p) < 11) ? ((p) < 6 ? (((p) & 1) ? 8 + ((p) >> 1) : ((p) >> 1)) : (p) - 3) : (p))
#define NA_KBASE(kt) (((kt) < nnb) ? b * SEQ + (kr_lo + (kt)) * 64 : ML + b * LC + 64 * ((kt) - nnb))
#define NA_LOAD(ip) do { _Pragma("unroll") for (int j = 0; j < 2; ++j) { const int pp_ = min(2 * (ip) + j, ntile - 1); const int kt_ = NA_TILE_OF(pp_); const int kbase = NA_KBASE(kt_); \
        rk[j] = *(const u32x4*)(QK1 + (size_t)(kbase + krr) * 2048 + 1024 + head * 64 + kch * 8); \
        rv[j] = *(const u32x4*)(VT1 + (size_t)(head * 64 + krr) * MT + kbase + kch * 8); } } while (0)
#define NA_STORE(st) do { _Pragma("unroll") for (int j = 0; j < 2; ++j) { LAS unsigned char* tb = F.lds + ((st) * 2 + j) * NA_TILE; \
        *(LAS u32x4*)(tb + krr * NA_KROWB + kch * 16) = rk[j]; \
        LAS unsigned char* d_ = tb + 64 * NA_KROWB + krr * VROW + kch * 16; *(LAS u32x2*)d_ = (u32x2){rv[j].x, rv[j].y}; *(LAS u32x2*)(d_ + 8) = (u32x2){rv[j].z, rv[j].w}; } } while (0)
    NA_LOAD(0); NA_STORE(0);
    if (npair > 1) NA_LOAD(1);
    __syncthreads();
    for (int ip = 0; ip < npair; ++ip) {
        if (ip + 1 < npair) NA_STORE((ip + 1) & 1);
        if (ip + 2 < npair) NA_LOAD(ip + 2);
#pragma unroll
        for (int sl = 0; sl < 2; ++sl) {
            if (2 * ip + sl >= ntile) continue;
            const int kt = NA_TILE_OF(2 * ip + sl);
            const bool nb = kt < nnb;
            const int krow = kr_lo + kt;
            if (nb && (krow < r0q || krow > r0q + 7)) continue;
            const LAS unsigned char* Ks = F.lds + ((ip & 1) * 2 + sl) * NA_TILE;
            f32x16 x[2];
            attn_scores<4, NA_KROWB>(Ks, r, h, qf, x, nin);
            if (nb) {
                const LAS float* bp = rpbs + ((krow - rq + 7) * 31 - cq + 15 + 4 * h);
                float bias[2][16];
#pragma unroll
                for (int kb = 0; kb < 2; ++kb)
#pragma unroll
                    for (int i = 0; i < 16; ++i) bias[kb][i] = bp[32 * kb + (i & 3) + 8 * (i >> 2)];
                asm volatile("" : "+v"(bias[0][0]));
#pragma unroll
                for (int kb = 0; kb < 2; ++kb)
#pragma unroll
                    for (int i = 0; i < 16; ++i) {
                        const int kc = 32 * kb + crow(i, h);
                        const bool valid = (unsigned)(kc - c0) <= 15u;
                        x[kb][i] = valid ? x[kb][i] + bias[kb][i] : NEG_BIG;
                    }
            }
            attn_softmax_pv(x, nin, m, ls, o, Ks + 64 * NA_KROWB, r, h);
        }
        __syncthreads();
    }
#undef NA_LOAD
#undef NA_STORE
#undef NA_KBASE
#undef NA_TILE_OF
    attn_store_f8(o, ls[0], (unsigned char*)O1 + (size_t)qrow * D + head * 64, h);
}

DI void norm_mod_row(const f32x4 (&v)[4], const float* g, const float* sc, const float* sh, bf16_t* orow, int lane) {
    float s = 0.f;
#pragma unroll
    for (int j = 0; j < 4; ++j) s += (v[j].x * v[j].x + v[j].y * v[j].y) + (v[j].z * v[j].z + v[j].w * v[j].w);
    const float rs = __builtin_amdgcn_rsqf(wave_sum(s) * (1.f / D) + EPS);
    u32x2* o8 = (u32x2*)orow + lane;
    f32x4 gg_[4], cc_[4], hh_[4];
#pragma unroll
    for (int j = 0; j < 4; ++j) { gg_[j] = ((const f32x4*)g)[lane + 64 * j]; cc_[j] = ((const f32x4*)sc)[lane + 64 * j]; hh_[j] = ((const f32x4*)sh)[lane + 64 * j]; }
#pragma unroll
    for (int j = 0; j < 4; ++j) {
        const f32x4 gg = gg_[j], cc = cc_[j], hh = hh_[j];
        f32x4 y;
#pragma unroll
        for (int k = 0; k < 4; ++k) y[k] = v[j][k] * rs * gg[k] * (1.f + cc[k]) + hh[k];
        u32x2 w; w.x = cvtpk(y[0], y[1]); w.y = cvtpk(y[2], y[3]); o8[64 * j] = w;
    }
}
template <bool XL16 = false, bool F8 = false>
DI void phase_norm_mod(Frame& F, const float* xl, const float* xc, int nrows, int layer, int sub, bf16_t* H, const float* part, int ks, const float* cgate, float* xcw) {
    const float* MOD = (const float*)(F.ws + WS_MOD) + (size_t)layer * 3 * 6144;
    const float* g = F.in[6] + (size_t)(layer * 2 + sub) * D;
    const int gw = F.bid * 8 + F.wave, NGW = F.G * 8;
    if (nrows > ML) {
        for (int cr = NGW - 1 - gw; cr < MC; cr += NGW) {
            const float* mr = MOD + (size_t)2 * 6144 + (sub ? 3 * D : 0);
            const f32x4* xr = (const f32x4*)(xc + (size_t)cr * D) + F.lane;
            f32x4 v[4]; float s = 0.f;
            if (ks > 0) {
                f32x4 a[4];
#pragma unroll
                for (int j = 0; j < 4; ++j) a[j] = (f32x4){0.f, 0.f, 0.f, 0.f};
                const f32x4* pp = (const f32x4*)(part + (size_t)cr * D) + F.lane;
#pragma unroll 1
                for (int e = 0; e < ks; e += 4) {
                    f32x4 t[4][4]; float wgt[4];
#pragma unroll
                    for (int i = 0; i < 4; ++i) { const int ec = min(e + i, ks - 1); wgt[i] = (e + i < ks) ? 1.f : 0.f;
#pragma unroll
                        for (int j = 0; j < 4; ++j) t[i][j] = pp[(size_t)ec * ((512 * 1024) / 4) + 64 * j]; }
#pragma unroll
                    for (int i = 0; i < 4; ++i)
#pragma unroll
                        for (int j = 0; j < 4; ++j) a[j] += wgt[i] * t[i][j];
                }
#pragma unroll
                for (int j = 0; j < 4; ++j) v[j] = xr[64 * j] + ((const f32x4*)cgate)[F.lane + 64 * j] * a[j];
                if (xcw) {
#pragma unroll
                    for (int j = 0; j < 4; ++j) ((f32x4*)(xcw + (size_t)cr * D))[F.lane + 64 * j] = v[j]; }
            } else {
#pragma unroll
                for (int j = 0; j < 4; ++j) v[j] = xr[64 * j];
            }
#pragma unroll
            for (int j = 0; j < 4; ++j) s += (v[j].x * v[j].x + v[j].y * v[j].y) + (v[j].z * v[j].z + v[j].w * v[j].w);
            const float rs = __builtin_amdgcn_rsqf(wave_sum(s) * (1.f / D) + EPS);
            u32x2* o8 = (u32x2*)(H + (size_t)(ML + cr) * D) + F.lane; unsigned* o4 = (unsigned*)((unsigned char*)H + (size_t)(ML + cr) * D) + F.lane;
            f32x4 gg_[4], cc_[4], hh_[4];
#pragma unroll
            for (int j = 0; j < 4; ++j) { gg_[j] = ((const f32x4*)g)[F.lane + 64 * j]; cc_[j] = ((const f32x4*)(mr + D))[F.lane + 64 * j]; hh_[j] = ((const f32x4*)mr)[F.lane + 64 * j]; }
#pragma unroll
            for (int j = 0; j < 4; ++j) {
                const f32x4 gg = gg_[j], cc = cc_[j], hh = hh_[j];
                f32x4 y;
#pragma unroll
                for (int k = 0; k < 4; ++k) y[k] = v[j][k] * rs * gg[k] * (1.f + cc[k]) + hh[k];
                if constexpr (F8) o4[64 * j] = pg8::cvt4_fp8(y[0] * 8.f, y[1] * 8.f, y[2] * 8.f, y[3] * 8.f);
                else { u32x2 w; w.x = cvtpk(y[0], y[1]); w.y = cvtpk(y[2], y[3]); o8[64 * j] = w; }
            }
        }
    }
    f32x4 nv[4];
    if constexpr (!XL16) { if (gw < ML) { const f32x4* xr = (const f32x4*)(xl + (size_t)gw * D) + F.lane;
#pragma unroll
        for (int j = 0; j < 4; ++j) nv[j] = __builtin_nontemporal_load(xr + 64 * j); } }
    u32x2 nx[4];
    if constexpr (XL16) { if (gw < ML) { const u32x2* xr = (const u32x2*)((const bf16_t*)xl + (size_t)gw * D) + F.lane;
#pragma unroll
        for (int j = 0; j < 4; ++j) nx[j] = xr[64 * j]; } }
    for (int row = gw; row < ML; row += NGW) {
        const int r = row < SEQ ? 0 : 1;
        const float* mr = MOD + (size_t)r * 6144 + (sub ? 3 * D : 0);
        if constexpr (!XL16) {
            f32x4 cv[4];
#pragma unroll
            for (int j = 0; j < 4; ++j) cv[j] = nv[j];
            if (row + NGW < ML) { const f32x4* xn = (const f32x4*)(xl + (size_t)(row + NGW) * D) + F.lane;
#pragma unroll
                for (int j = 0; j < 4; ++j) nv[j] = __builtin_nontemporal_load(xn + 64 * j); }
            norm_mod_row(cv, g, mr + D, mr, H + (size_t)row * D, F.lane);
        } else {
            u32x2 cx[4];
#pragma unroll
            for (int j = 0; j < 4; ++j) cx[j] = nx[j];
            if (row + NGW < ML) { const u32x2* xn = (const u32x2*)((const bf16_t*)xl + (size_t)(row + NGW) * D) + F.lane;
#pragma unroll
                for (int j = 0; j < 4; ++j) nx[j] = xn[64 * j]; }
            f32x4 v[4]; float ssq = 0.f;
#pragma unroll
            for (int j = 0; j < 4; ++j) { const u32x2 a = cx[j]; v[j] = (f32x4){bflo(a.x), bfhi(a.x), bflo(a.y), bfhi(a.y)}; ssq += (v[j].x * v[j].x + v[j].y * v[j].y) + (v[j].z * v[j].z + v[j].w * v[j].w); }
            const float rs = __builtin_amdgcn_rsqf(wave_sum(ssq) * (1.f / D) + EPS);
            u32x2* o8 = (u32x2*)(H + (size_t)row * D) + F.lane; unsigned* o4 = (unsigned*)((unsigned char*)H + (size_t)row * D) + F.lane;
            f32x4 gg_[4], cc_[4], hh_[4];
#pragma unroll
            for (int j = 0; j < 4; ++j) { gg_[j] = ((const f32x4*)g)[F.lane + 64 * j]; cc_[j] = ((const f32x4*)(mr + D))[F.lane + 64 * j]; hh_[j] = ((const f32x4*)mr)[F.lane + 64 * j]; }
#pragma unroll
            for (int j = 0; j < 4; ++j) {
                const f32x4 gg = gg_[j], cc = cc_[j], hh = hh_[j];
                f32x4 y;
#pragma unroll
                for (int k = 0; k < 4; ++k) y[k] = v[j][k] * rs * gg[k] * (1.f + cc[k]) + hh[k];
                if constexpr (F8) o4[64 * j] = pg8::cvt4_fp8(y[0] * 8.f, y[1] * 8.f, y[2] * 8.f, y[3] * 8.f);
                else { u32x2 w; w.x = cvtpk(y[0], y[1]); w.y = cvtpk(y[2], y[3]); o8[64 * j] = w; }
            }
        }
    }
}

DI void phase_prep(Frame& F) {
    const bf16_t* QKVP = (const bf16_t*)(F.ws + WS_QKVP); bf16_t* QKVC = (bf16_t*)(F.ws + WS_QKVC); bf16_t* CQKV = (bf16_t*)(F.ws + WS_CQKV);
    const float* AB = (const float*)(F.ws + WS_AB); float* GB = (float*)(F.ws + WS_GB); const float* ROPE = (const float*)(F.ws + WS_ROPE);
    LAS float* cw = (LAS float*)F.lds;
    __syncthreads();
    for (int i = F.tid; i < 5 * 1536; i += 512) cw[i] = F.in[8][i];
    __syncthreads();
    const float* a_log = F.in[9]; const float* dt_bias = F.in[10]; const float* qg = F.in[12]; const float* kvg = F.in[14];
    const int lane = F.lane;
    const int gw = F.bid * 8 + F.wave, NGW = F.G * 8;
    const float dtb_ = dt_bias[lane & 7], nal_ = -__expf(a_log[lane & 7]);
    float qg8[8], kg8[8];
    { const f32x4 a0 = *(const f32x4*)(qg + min(lane, 47) * 8), a1 = *(const f32x4*)(qg + min(lane, 47) * 8 + 4), b0 = *(const f32x4*)(kvg + (lane & 31) * 8), b1 = *(const f32x4*)(kvg + (lane & 31) * 8 + 4);
#pragma unroll
      for (int j = 0; j < 4; ++j) { qg8[j] = a0[j]; qg8[4 + j] = a1[j]; kg8[j] = b0[j]; kg8[4 + j] = b1[j]; } }
    for (int row = gw; row < MT; row += NGW) {
        int t, len, rbase;
        if (row < ML) { t = row & (SEQ - 1); len = SEQ; rbase = row - t; } else { t = (row - ML) & (LC - 1); len = LC; rbase = row - t; }
        u32x4 rawc[3][5];
#pragma unroll
        for (int part = 0; part < 3; ++part)
#pragma unroll
            for (int k = 0; k < 5; ++k) { const int tc = min(max(t + k - 2, 0), len - 1);
                rawc[part][k] = *(const u32x4*)(QKVP + (size_t)(rbase + tc) * 1536 + part * 512 + lane * 8); }
        const bf16_t* crl = CQKV + (size_t)row * 768;
        const u32x4 rawq = *(const u32x4*)(crl + min(lane, 47) * 8), rawk = *(const u32x4*)(crl + 384 + (lane & 31) * 8), rawr = *(const u32x4*)(crl + 640 + (lane & 3) * 8);
        const float ab_a = AB[(size_t)row * 16 + (lane & 7)], ab_b = AB[(size_t)row * 16 + 8 + (lane & 7)];
        const int tr_ = row < ML ? t : 0;
        const f32x4 rcs = *(const f32x4*)(ROPE + (size_t)tr_ * 16 + 4 * (lane & 3)), rsn = *(const f32x4*)(ROPE + (size_t)SEQ * 16 + (size_t)tr_ * 16 + 4 * (lane & 3));
#pragma unroll
        for (int part = 0; part < 3; ++part) {
            const int c0 = part * 512 + lane * 8;
            float acc[8];
#pragma unroll
            for (int j = 0; j < 8; ++j) acc[j] = 0.f;
#pragma unroll
            for (int k = 0; k < 5; ++k) {
                const int tt = t + k - 2;
                if (tt >= 0 && tt < len) {
                    const u32x4 raw = rawc[part][k];
                    const f32x4 w0 = *(const LAS f32x4*)(cw + k * 1536 + c0), w1 = *(const LAS f32x4*)(cw + k * 1536 + c0 + 4);
                    acc[0] += bflo(raw.x) * w0[0]; acc[1] += bfhi(raw.x) * w0[1]; acc[2] += bflo(raw.y) * w0[2]; acc[3] += bfhi(raw.y) * w0[3];
                    acc[4] += bflo(raw.z) * w1[0]; acc[5] += bfhi(raw.z) * w1[1]; acc[6] += bflo(raw.w) * w1[2]; acc[7] += bfhi(raw.w) * w1[3];
                }
            }
            float ss = 0.f;
#pragma unroll
            for (int j = 0; j < 8; ++j) { acc[j] = siluf(acc[j]); ss += acc[j] * acc[j]; }
            if (part < 2) {
                ss += __shfl_xor(ss, 1); ss += __shfl_xor(ss, 2); ss += __shfl_xor(ss, 4); ss += __shfl_xor(ss, 8);
                const float rn = __builtin_amdgcn_rsqf(ss + 1e-6f);
#pragma unroll
                for (int j = 0; j < 8; ++j) acc[j] *= rn;
            }
            u32x4 w; w.x = cvtpk(acc[0], acc[1]); w.y = cvtpk(acc[2], acc[3]); w.z = cvtpk(acc[4], acc[5]); w.w = cvtpk(acc[6], acc[7]);
            *(u32x4*)(QKVC + (size_t)row * 1536 + c0) = w;
        }
        if (lane < 8) {
            const float a = ab_a, bg = ab_b;
            const float xx = a + dtb_;
            const float sp = xx > 20.f ? xx : log1pf(__expf(xx));
            GB[(size_t)row * 16 + lane] = nal_ * sp;
            GB[(size_t)row * 16 + 8 + lane] = sigmoidf(bg);
        }
        bf16_t* cr = CQKV + (size_t)row * 768;
        {
            float q8[8], k8[8]; float sq = 0.f, sk = 0.f;
            if (lane < 48) { const u32x4 raw = rawq;
                q8[0] = bflo(raw.x); q8[1] = bfhi(raw.x); q8[2] = bflo(raw.y); q8[3] = bfhi(raw.y); q8[4] = bflo(raw.z); q8[5] = bfhi(raw.z); q8[6] = bflo(raw.w); q8[7] = bfhi(raw.w);
#pragma unroll
                for (int j = 0; j < 8; ++j) sq += q8[j] * q8[j]; }
            if (lane < 32) { const u32x4 raw = rawk;
                k8[0] = bflo(raw.x); k8[1] = bfhi(raw.x); k8[2] = bflo(raw.y); k8[3] = bfhi(raw.y); k8[4] = bflo(raw.z); k8[5] = bfhi(raw.z); k8[6] = bflo(raw.w); k8[7] = bfhi(raw.w);
#pragma unroll
                for (int j = 0; j < 8; ++j) sk += k8[j] * k8[j]; }
            const u32x4 krw = rawr;
            sq = wave_sum(sq); sk = wave_sum(sk);
            const float rq = __builtin_amdgcn_rsqf(sq * (1.f / 384.f) + EPS), rk = __builtin_amdgcn_rsqf(sk * (1.f / 256.f) + EPS);
            if (lane < 48) { u32x4 w; const float* gp = qg8;
                w.x = cvtpk(q8[0] * rq * gp[0], q8[1] * rq * gp[1]); w.y = cvtpk(q8[2] * rq * gp[2], q8[3] * rq * gp[3]);
                w.z = cvtpk(q8[4] * rq * gp[4], q8[5] * rq * gp[5]); w.w = cvtpk(q8[6] * rq * gp[6], q8[7] * rq * gp[7]);
                *(u32x4*)(cr + lane * 8) = w; }
            if (lane < 32) { u32x4 w; const float* gp = kg8;
                w.x = cvtpk(k8[0] * rk * gp[0], k8[1] * rk * gp[1]); w.y = cvtpk(k8[2] * rk * gp[2], k8[3] * rk * gp[3]);
                w.z = cvtpk(k8[4] * rk * gp[4], k8[5] * rk * gp[5]); w.w = cvtpk(k8[6] * rk * gp[6], k8[7] * rk * gp[7]);
                *(u32x4*)(cr + 384 + lane * 8) = w; }
            if (lane < 4) {
                u32x4 w = krw;
                if (row < ML) {
                    float v[8]; v[0] = bflo(krw.x); v[1] = bfhi(krw.x); v[2] = bflo(krw.y); v[3] = bfhi(krw.y); v[4] = bflo(krw.z); v[5] = bfhi(krw.z); v[6] = bflo(krw.w); v[7] = bfhi(krw.w);
                    const f32x4 cs = rcs, sn = rsn;
#pragma unroll
                    for (int p = 0; p < 4; ++p) { const float a = v[2 * p], bb = v[2 * p + 1]; v[2 * p] = a * cs[p] - bb * sn[p]; v[2 * p + 1] = bb * cs[p] + a * sn[p]; }
                    w.x = cvtpk(v[0], v[1]); w.y = cvtpk(v[2], v[3]); w.z = cvtpk(v[4], v[5]); w.w = cvtpk(v[6], v[7]);
                }
                *(u32x4*)((bf16_t*)(F.ws + WS_KR) + (size_t)row * 32 + lane * 8) = w;
            }
        }
    }
}

DI int gdn_base(int b, int cn) { return cn < 4 ? ML + b * LC + 64 * cn : b * SEQ + 64 * (cn - 4); }
DI void gdn_chunk_unit(Frame& F, int uidx) {
    const int b = uidx / (4 * NCHUNK), h = (uidx / NCHUNK) & 3, cn = uidx % NCHUNK;
    const int base = gdn_base(b, cn);
    const bf16_t* QKVC = (const bf16_t*)(F.ws + WS_QKVC); const float* GB = (const float*)(F.ws + WS_GB);
    bf16_t* GU = (bf16_t*)(F.ws + WS_GU); bf16_t* GW = (bf16_t*)(F.ws + WS_GW); bf16_t* GQK = (bf16_t*)(F.ws + WS_GQK); float* GC = (float*)(F.ws + WS_GC);
    LAS float* As = (LAS float*)F.lds;
    LAS float* gcs = (LAS float*)(F.lds + 32768);
    LAS float* bts = (LAS float*)(F.lds + 32768 + 512);
    LAS float* rfs = (LAS float*)(F.lds + 32768 + 1024);
    int lane = F.lane, tid_ = F.tid; const int wave = F.wave;
    asm volatile("" : "+v"(lane), "+v"(tid_));
    __syncthreads();
    unsigned short xraw[64];
    { const int dir_ = tid_ >> 8, c_ = tid_ & 255; const bool isw_ = c_ >= 128;
      const bf16_t* pp = QKVC + (isw_ ? 512 : 1024) + h * 128 + (c_ & 127) + (size_t)(base + (dir_ ? 63 : 0)) * 1536;
      const long st = dir_ ? -1536 : 1536;
#pragma unroll
      for (int i = 0; i < 64; ++i) { xraw[i] = *(const unsigned short*)pp; pp += st; } }
    if (wave < 2) {
        const int dir = wave, i = lane, tok = base + (dir ? 63 - i : i);
        float g = GB[(size_t)tok * 16 + dir * 4 + h]; const float bt = GB[(size_t)tok * 16 + 8 + dir * 4 + h];
#pragma unroll
        for (int o = 1; o < 64; o <<= 1) { const float up = __shfl_up(g, o); if (lane >= o) g += up; }
        gcs[dir * 64 + i] = g; bts[dir * 64 + i] = bt;
        rfs[dir * 128 + i] = bt; rfs[dir * 128 + 64 + i] = bt * __expf(g);
        GC[(size_t)((((b * 4 + h) * 2 + dir) * NCHUNK + cn)) * 64 + i] = g;
    }
    __syncthreads();
    const int r = lane & 31, hh = lane >> 5;
    for (int task = wave; task < 12; task += 8) {
        const int dir = task / 6, kind = (task % 6) / 3, blk = task % 3;
        const int bi = blk ? 1 : 0, bj = blk == 2 ? 1 : 0;
        const size_t uid = (size_t)(((b * 4 + h) * 2 + dir) * NCHUNK + cn);
        f32x16 x;
#pragma unroll
        for (int i = 0; i < 16; ++i) x[i] = 0.f;
        if (kind == 0) {
            const int jr = 32 * bj + r, ir = 32 * bi + r;
            const int tokj = base + (dir ? 63 - jr : jr), toki = base + (dir ? 63 - ir : ir);
            const bf16_t* pa = QKVC + (size_t)tokj * 1536 + 512 + h * 128 + 8 * hh;
            const bf16_t* pb = QKVC + (size_t)toki * 1536 + 512 + h * 128 + 8 * hh;
#pragma unroll
            for (int s = 0; s < 8; ++s) { const bf16x8 a = *(const bf16x8*)(pa + 16 * s), bb = *(const bf16x8*)(pb + 16 * s); x = MFMA32(a, bb, x); }
            const float gi = gcs[dir * 64 + ir], bti = bts[dir * 64 + ir];
#pragma unroll
            for (int i = 0; i < 16; ++i) {
                const int jj = 32 * bj + crow(i, hh);
                const float e = __expf(gi - gcs[dir * 64 + jj]);
                As[dir * 4096 + jj * 64 + ir] = (jj < ir) ? bti * x[i] * e : 0.f;
            }
        } else {
            const int ia = 32 * bi + r, jb = 32 * bj + r;
            const int toka = base + (dir ? 63 - ia : ia), tokb = base + (dir ? 63 - jb : jb);
            const bf16_t* pa = QKVC + (size_t)toka * 1536 + h * 128 + 8 * hh;
            const bf16_t* pb = QKVC + (size_t)tokb * 1536 + 512 + h * 128 + 8 * hh;
#pragma unroll
            for (int s = 0; s < 8; ++s) { const bf16x8 a = *(const bf16x8*)(pa + 16 * s), bb = *(const bf16x8*)(pb + 16 * s); x = MFMA32(a, bb, x); }
            const float gj = gcs[dir * 64 + jb];
#pragma unroll
            for (int i = 0; i < 16; ++i) {
                const int ii = 32 * bi + crow(i, hh);
                const float dec = __expf(gcs[dir * 64 + ii] - gj);
                GQK[uid * 4096 + ii * 64 + jb] = (bf16_t)f2bf((jb <= ii) ? x[i] * 0.08838834764831845f * dec : 0.f);
            }
        }
    }
    {
        const int dir = tid_ >> 8, idx = tid_ & 255, i = idx >> 3, j4 = 32 + (idx & 7) * 4;
        const size_t uid = (size_t)(((b * 4 + h) * 2 + dir) * NCHUNK + cn);
        *(u32x2*)(GQK + uid * 4096 + i * 64 + j4) = (u32x2){0u, 0u};
    }
    __syncthreads();
    {
        const int dir = tid_ >> 8, c = tid_ & 255;
        const size_t uid = (size_t)(((b * 4 + h) * 2 + dir) * NCHUNK + cn);
        const LAS float* A = As + dir * 4096;
        float x[64];
        const bool isw = c >= 128; const int cc = c & 127;
        const bf16_t* src = QKVC + (isw ? 512 : 1024) + h * 128 + cc;
        {
#pragma unroll
            for (int i = 0; i < 64; ++i) x[i] = bf2f(xraw[i]);
            const LAS float* rf = rfs + dir * 128 + (isw ? 64 : 0);
            __builtin_amdgcn_sched_barrier(0);
#pragma unroll
            for (int i = 0; i < 64; ++i) { x[i] *= rf[i]; if ((i & 15) == 15) __builtin_amdgcn_sched_barrier(0); }
        }
        f32x4 av[8];
#define SUBST_HALF(j, Q0) do { \
            _Pragma("unroll") for (int q = 0; q < 8; ++q) if ((Q0) + q >= (((j) + 1) >> 2)) av[q] = ((const LAS f32x4*)(A + (j) * 64))[(Q0) + q]; \
            _Pragma("unroll") for (int q = 0; q < 8; ++q) if ((Q0) + q >= (((j) + 1) >> 2)) asm volatile("" : "+v"(av[q])); \
            _Pragma("unroll") for (int q = 0; q < 8; ++q) _Pragma("unroll") for (int k = 0; k < 4; ++k) { const int i = 4 * ((Q0) + q) + k; if (i > (j)) x[i] -= av[q][k] * xj; } \
            } while (0)
#define SUBST_COL(j) do { const float xj = x[(j)]; if ((j) < 31) SUBST_HALF(j, 0); SUBST_HALF(j, 8); } while (0)
        SUBST_COL(0); SUBST_COL(1); SUBST_COL(2); SUBST_COL(3); SUBST_COL(4); SUBST_COL(5); SUBST_COL(6); SUBST_COL(7);
        SUBST_COL(8); SUBST_COL(9); SUBST_COL(10); SUBST_COL(11); SUBST_COL(12); SUBST_COL(13); SUBST_COL(14); SUBST_COL(15);
        SUBST_COL(16); SUBST_COL(17); SUBST_COL(18); SUBST_COL(19); SUBST_COL(20); SUBST_COL(21); SUBST_COL(22); SUBST_COL(23);
        SUBST_COL(24); SUBST_COL(25); SUBST_COL(26); SUBST_COL(27); SUBST_COL(28); SUBST_COL(29); SUBST_COL(30); SUBST_COL(31);
        SUBST_COL(32); SUBST_COL(33); SUBST_COL(34); SUBST_COL(35); SUBST_COL(36); SUBST_COL(37); SUBST_COL(38); SUBST_COL(39);
        SUBST_COL(40); SUBST_COL(41); SUBST_COL(42); SUBST_COL(43); SUBST_COL(44); SUBST_COL(45); SUBST_COL(46); SUBST_COL(47);
        SUBST_COL(48); SUBST_COL(49); SUBST_COL(50); SUBST_COL(51); SUBST_COL(52); SUBST_COL(53); SUBST_COL(54); SUBST_COL(55);
        SUBST_COL(56); SUBST_COL(57); SUBST_COL(58); SUBST_COL(59); SUBST_COL(60); SUBST_COL(61); SUBST_COL(62);
#undef SUBST_COL
#undef SUBST_HALF
        if (isw) {
            bf16_t* dst = GW + uid * 8192 + cc;
#pragma unroll
            for (int i = 0; i < 64; ++i) dst[i * 128] = (bf16_t)f2bf(-x[i]);
        } else {
            bf16_t* dst = GU + uid * 8192 + (size_t)((cc >> 5) * 2) * 1024 + (cc & 31) * 16;
#pragma unroll
            for (int i = 0; i < 64; ++i) { const int it = i >> 5, ip = i & 31, reg = (ip & 3) + 4 * (ip >> 3), hq = (ip >> 2) & 1;
                dst[it * 1024 + hq * 512 + reg] = (bf16_t)f2bf(x[i]); }
        }
    }
}

constexpr int SC_NW = 0, SC_QS = 16896, SC_KT = 33792, SC_QM = 51200, SC_BUF = 59904;
DI bf16x8 rd_frag(const LAS unsigned char* p) { const s16x4 lo = *(const LAS s16x4*)p, hi = *(const LAS s16x4*)(p + 16); return __builtin_shufflevector(lo, hi, 0, 1, 2, 3, 4, 5, 6, 7); }
DI bf16x8 pack8(const f32x16& x, int s2) {
    u32x4 p; p.x = cvtpk(x[8 * s2 + 0], x[8 * s2 + 1]); p.y = cvtpk(x[8 * s2 + 2], x[8 * s2 + 3]); p.z = cvtpk(x[8 * s2 + 4], x[8 * s2 + 5]); p.w = cvtpk(x[8 * s2 + 6], x[8 * s2 + 7]);
    return __builtin_bit_cast(bf16x8, p);
}
DI u32x4 scale8(u32x4 v, float f) {
    u32x4 o; o.x = cvtpk(bflo(v.x) * f, bfhi(v.x) * f); o.y = cvtpk(bflo(v.y) * f, bfhi(v.y) * f); o.z = cvtpk(bflo(v.z) * f, bfhi(v.z) * f); o.w = cvtpk(bflo(v.w) * f, bfhi(v.w) * f); return o;
}
DI void gdn_scan(Frame& F, int seq) {
    const int b = seq >> 3, h = (seq >> 1) & 3, dir = seq & 1;
    const bf16_t* QKVC = (const bf16_t*)(F.ws + WS_QKVC);
    const bf16_t* GU = (const bf16_t*)(F.ws + WS_GU); const bf16_t* GW = (const bf16_t*)(F.ws + WS_GW); const bf16_t* GQK = (const bf16_t*)(F.ws + WS_GQK); const float* GC = (const float*)(F.ws + WS_GC);
    bf16_t* OFB = (bf16_t*)(F.ws + WS_OFB) + (size_t)dir * MT * 512;
    const int tid = F.tid, lane = F.lane, wave = F.wave;
    const size_t uid0 = (size_t)(((b * 4 + h) * 2 + dir) * NCHUNK);
#define SC_CN(n) (dir ? ((n) < 4 ? 3 - (n) : 131 - ((n) - 4)) : (n))
    __syncthreads();
    if (wave >= 4) {
        const int lt = tid - 256;
        const int wi = lt >> 4, wch = lt & 15;
        const int ki0 = 4 * (lt >> 4);
        const int mi = lt >> 3, mch = lt & 7;
        u32x4 rw[4], rq[4], rk[4], rm[2]; float gq[4], gk[4], g63 = 0.f;
#define SC_LOAD(n) do { const int cn_ = SC_CN(n); const int base_ = gdn_base(b, cn_); const size_t uid_ = uid0 + cn_; \
            _Pragma("unroll") for (int rep = 0; rep < 4; ++rep) { const int i_ = wi + 16 * rep; const int tok_ = base_ + (dir ? 63 - i_ : i_); \
                rw[rep] = *(const u32x4*)(GW + uid_ * 8192 + i_ * 128 + wch * 8); rq[rep] = *(const u32x4*)(QKVC + (size_t)tok_ * 1536 + h * 128 + wch * 8); gq[rep] = GC[uid_ * 64 + i_]; } \
            _Pragma("unroll") for (int k = 0; k < 4; ++k) { const int i_ = ki0 + k; const int tok_ = base_ + (dir ? 63 - i_ : i_); \
                rk[k] = *(const u32x4*)(QKVC + (size_t)tok_ * 1536 + 512 + h * 128 + wch * 8); gk[k] = GC[uid_ * 64 + i_]; } \
            _Pragma("unroll") for (int rep = 0; rep < 2; ++rep) rm[rep] = *(const u32x4*)(GQK + uid_ * 4096 + (mi + 32 * rep) * 64 + mch * 8); \
            g63 = GC[uid_ * 64 + 63]; } while (0)
#define SC_STORE(bufp) do { LAS unsigned char* bp_ = (bufp); \
            _Pragma("unroll") for (int rep = 0; rep < 4; ++rep) { const int i_ = wi + 16 * rep; \
                LAS unsigned char* d_ = bp_ + SC_NW + i_ * 264 + wch * 16; *(LAS u32x2*)d_ = (u32x2){rw[rep].x, rw[rep].y}; *(LAS u32x2*)(d_ + 8) = (u32x2){rw[rep].z, rw[rep].w}; \
                const u32x4 q_ = scale8(rq[rep], __expf(gq[rep]) * 0.08838834764831845f); \
                LAS unsigned char* e_ = bp_ + SC_QS + i_ * 264 + wch * 16; *(LAS u32x2*)e_ = (u32x2){q_.x, q_.y}; *(LAS u32x2*)(e_ + 8) = (u32x2){q_.z, q_.w}; } \
            { u32x4 ks_[4]; _Pragma("unroll") for (int k = 0; k < 4; ++k) ks_[k] = scale8(rk[k], __expf(g63 - gk[k])); \
              _Pragma("unroll") for (int c = 0; c < 4; ++c) { \
                  const unsigned a0 = ks_[0][c], a1 = ks_[1][c], a2 = ks_[2][c], a3 = ks_[3][c]; \
                  LAS unsigned char* d_ = bp_ + SC_KT + (wch * 8 + 2 * c) * 136 + ki0 * 2; \
                  *(LAS u32x2*)d_ = (u32x2){(a0 & 0xffffu) | (a1 << 16), (a2 & 0xffffu) | (a3 << 16)}; \
                  *(LAS u32x2*)(d_ + 136) = (u32x2){(a0 >> 16) | (a1 & 0xffff0000u), (a2 >> 16) | (a3 & 0xffff0000u)}; } } \
            _Pragma("unroll") for (int rep = 0; rep < 2; ++rep) { LAS unsigned char* d_ = bp_ + SC_QM + (mi + 32 * rep) * 136 + mch * 16; \
                *(LAS u32x2*)d_ = (u32x2){rm[rep].x, rm[rep].y}; *(LAS u32x2*)(d_ + 8) = (u32x2){rm[rep].z, rm[rep].w}; } } while (0)
        SC_LOAD(0); SC_STORE(F.lds); SC_LOAD(1);
        for (int n = 0; n < NCHUNK; ++n) {
            __syncthreads();
            if (n + 1 < NCHUNK) { SC_STORE(F.lds + ((n + 1) & 1) * SC_BUF); }
            if (n + 2 < NCHUNK) { SC_LOAD(n + 2); }
        }
#undef SC_LOAD
#undef SC_STORE
    } else {
        const int r = lane & 31, hh = lane >> 5, c0 = 32 * wave;
        f32x16 S[4];
#pragma unroll
        for (int t = 0; t < 4; ++t)
#pragma unroll
            for (int i = 0; i < 16; ++i) S[t][i] = 0.f;
        u32x4 un[2][2];
#define SC_ULOAD(n) do { const size_t uid_ = uid0 + SC_CN(n); _Pragma("unroll") for (int it = 0; it < 2; ++it) { const u32x4* up_ = (const u32x4*)(GU + uid_ * 8192 + ((size_t)((wave * 2 + it) * 64 + lane)) * 16); un[it][0] = up_[0]; un[it][1] = up_[1]; } } while (0)
        SC_ULOAD(0);
        float gc_next = GC[(uid0 + SC_CN(0)) * 64 + 63];
        for (int n = 0; n < NCHUNK; ++n) {
            __syncthreads();
            const LAS unsigned char* bp = F.lds + (n & 1) * SC_BUF;
            const int cn = SC_CN(n); const int base = gdn_base(b, cn);
            const float gl = __expf(gc_next);
            if (n + 1 < NCHUNK) gc_next = GC[(uid0 + SC_CN(n + 1)) * 64 + 63];
            f32x16 V[2];
#pragma unroll
            for (int it = 0; it < 2; ++it) {
                V[it][0] = bflo(un[it][0].x); V[it][1] = bfhi(un[it][0].x); V[it][2] = bflo(un[it][0].y); V[it][3] = bfhi(un[it][0].y);
                V[it][4] = bflo(un[it][0].z); V[it][5] = bfhi(un[it][0].z); V[it][6] = bflo(un[it][0].w); V[it][7] = bfhi(un[it][0].w);
                V[it][8] = bflo(un[it][1].x); V[it][9] = bfhi(un[it][1].x); V[it][10] = bflo(un[it][1].y); V[it][11] = bfhi(un[it][1].y);
                V[it][12] = bflo(un[it][1].z); V[it][13] = bfhi(un[it][1].z); V[it][14] = bflo(un[it][1].w); V[it][15] = bfhi(un[it][1].w);
            }
            if (n + 1 < NCHUNK) SC_ULOAD(n + 1);
            bf16x8 Sp[4][2];
#pragma unroll
            for (int t = 0; t < 4; ++t) { Sp[t][0] = pack8(S[t], 0); Sp[t][1] = pack8(S[t], 1); }
#define SC_PIN8(fr) do { _Pragma("unroll") for (int k_ = 0; k_ < 8; ++k_) asm volatile("" : "+v"(fr[k_])); } while (0)
#pragma unroll
            for (int it = 0; it < 2; ++it) {
                bf16x8 fr[8];
#pragma unroll
                for (int t = 0; t < 4; ++t)
#pragma unroll
                    for (int s2 = 0; s2 < 2; ++s2) fr[t * 2 + s2] = rd_frag(bp + SC_NW + (32 * it + r) * 264 + (32 * t + 16 * s2 + 4 * hh) * 2);
                SC_PIN8(fr);
#pragma unroll
                for (int t = 0; t < 4; ++t)
#pragma unroll
                    for (int s2 = 0; s2 < 2; ++s2) V[it] = MFMA32(fr[t * 2 + s2], Sp[t][s2], V[it]);
            }
            bf16x8 Vp[2][2];
#pragma unroll
            for (int it = 0; it < 2; ++it) { Vp[it][0] = pack8(V[it], 0); Vp[it][1] = pack8(V[it], 1); }
#pragma unroll
            for (int tp = 0; tp < 2; ++tp) {
                bf16x8 fr[8];
#pragma unroll
                for (int tt = 0; tt < 2; ++tt)
#pragma unroll
                    for (int it = 0; it < 2; ++it)
#pragma unroll
                        for (int s2 = 0; s2 < 2; ++s2) fr[tt * 4 + it * 2 + s2] = rd_frag(bp + SC_KT + (32 * (2 * tp + tt) + r) * 136 + (32 * it + 16 * s2 + 4 * hh) * 2);
                SC_PIN8(fr);
#pragma unroll
                for (int tt = 0; tt < 2; ++tt) { const int t = 2 * tp + tt;
#pragma unroll
                    for (int i = 0; i < 16; ++i) S[t][i] *= gl;
#pragma unroll
                    for (int it = 0; it < 2; ++it)
#pragma unroll
                        for (int s2 = 0; s2 < 2; ++s2) S[t] = MFMA32(fr[tt * 4 + it * 2 + s2], Vp[it][s2], S[t]);
                }
            }
#pragma unroll
            for (int it = 0; it < 2; ++it) {
                f32x16 O;
#pragma unroll
                for (int i = 0; i < 16; ++i) O[i] = 0.f;
                {
                    bf16x8 fr[8], fm[4];
#pragma unroll
                    for (int t = 0; t < 4; ++t)
#pragma unroll
                        for (int s2 = 0; s2 < 2; ++s2) fr[t * 2 + s2] = rd_frag(bp + SC_QS + (32 * it + r) * 264 + (32 * t + 16 * s2 + 4 * hh) * 2);
#pragma unroll
                    for (int jt = 0; jt <= it; ++jt)
#pragma unroll
                        for (int s2 = 0; s2 < 2; ++s2) fm[jt * 2 + s2] = rd_frag(bp + SC_QM + (32 * it + r) * 136 + (32 * jt + 16 * s2 + 4 * hh) * 2);
                    SC_PIN8(fr);
#pragma unroll
                    for (int k_ = 0; k_ < 2 * (it + 1); ++k_) asm volatile("" : "+v"(fm[k_]));
#pragma unroll
                    for (int t = 0; t < 4; ++t)
#pragma unroll
                        for (int s2 = 0; s2 < 2; ++s2) O = MFMA32(fr[t * 2 + s2], Sp[t][s2], O);
#pragma unroll
                    for (int jt = 0; jt <= it; ++jt)
#pragma unroll
                        for (int s2 = 0; s2 < 2; ++s2) O = MFMA32(fm[jt * 2 + s2], Vp[jt][s2], O);
                }
                const unsigned lo_ = (unsigned)((((dir ? -4 * hh : 4 * hh) * 512) + h * 128 + c0 + r) * 2);
                char* ub_ = (char*)OFB + (ptrdiff_t)(base + (dir ? 63 : 0)) * 1024;
                const ptrdiff_t rs_ = dir ? -1024 : 1024;
#pragma unroll
                for (int i = 0; i < 16; ++i) {
                    const int ci = 32 * it + (i & 3) + 8 * (i >> 2);
                    *(bf16_t*)(ub_ + ci * rs_ + (ptrdiff_t)(int)lo_) = (bf16_t)(cvtpk(O[i], 0.f) & 0xffffu);
                }
            }
        }
#undef SC_ULOAD
#undef SC_PIN8
    }
#undef SC_CN
    __syncthreads();
}

DI void gdn_out_rows(Frame& F, int row_begin, int row_end);
DI void phase_gdn_out(Frame& F) {
    const bf16_t* OF = (const bf16_t*)(F.ws + WS_OFB); const bf16_t* OB = OF + (size_t)MT * 512; const bf16_t* Z = (const bf16_t*)(F.ws + WS_Z);
    bf16_t* MIX = (bf16_t*)(F.ws + WS_H);
    const float* gg = F.in[11] + (F.lane & 15) * 8;
    const int gw = F.bid * 8 + F.wave, NGW = F.G * 8;
    for (int row = gw; row < MT; row += NGW) {
        const u32x4 a = *(const u32x4*)(OF + (size_t)row * 512 + F.lane * 8), bq = *(const u32x4*)(OB + (size_t)row * 512 + F.lane * 8), zz = *(const u32x4*)(Z + (size_t)row * 512 + F.lane * 8);
        float o[8], z[8];
        o[0] = bflo(a.x) + bflo(bq.x); o[1] = bfhi(a.x) + bfhi(bq.x); o[2] = bflo(a.y) + bflo(bq.y); o[3] = bfhi(a.y) + bfhi(bq.y);
        o[4] = bflo(a.z) + bflo(bq.z); o[5] = bfhi(a.z) + bfhi(bq.z); o[6] = bflo(a.w) + bflo(bq.w); o[7] = bfhi(a.w) + bfhi(bq.w);
        z[0] = bflo(zz.x); z[1] = bfhi(zz.x); z[2] = bflo(zz.y); z[3] = bfhi(zz.y); z[4] = bflo(zz.z); z[5] = bfhi(zz.z); z[6] = bflo(zz.w); z[7] = bfhi(zz.w);
        float ss = 0.f;
#pragma unroll
        for (int j = 0; j < 8; ++j) ss += o[j] * o[j];
        ss += __shfl_xor(ss, 1); ss += __shfl_xor(ss, 2); ss += __shfl_xor(ss, 4); ss += __shfl_xor(ss, 8);
        const float rn = __builtin_amdgcn_rsqf(ss * (1.f / 128.f) + EPS);
        float y[8];
#pragma unroll
        for (int j = 0; j < 8; ++j) y[j] = o[j] * rn * gg[j] * siluf(z[j]);
        u32x4 w; w.x = cvtpk(y[0], y[1]); w.y = cvtpk(y[2], y[3]); w.z = cvtpk(y[4], y[5]); w.w = cvtpk(y[6], y[7]);
        *(u32x4*)(MIX + (size_t)row * D + F.lane * 8) = w;
    }
}

DI void gdn_out_rows(Frame& F, int row_begin, int row_end) {
    const bf16_t* OF = (const bf16_t*)(F.ws + WS_OFB); const bf16_t* OB = OF + (size_t)MT * 512; const bf16_t* Z = (const bf16_t*)(F.ws + WS_Z);
    bf16_t* MIX = (bf16_t*)(F.ws + WS_H);
    float g8[8];
    { const f32x4 g0 = *(const f32x4*)(F.in[11] + (F.lane & 15) * 8), g1 = *(const f32x4*)(F.in[11] + (F.lane & 15) * 8 + 4);
#pragma unroll
      for (int j = 0; j < 4; ++j) { g8[j] = g0[j]; g8[4 + j] = g1[j]; } }
    for (int row0 = row_begin + F.wave; row0 < row_end; row0 += 32) {
        u32x4 a[4], bq[4], zz[4];
#pragma unroll
        for (int i = 0; i < 4; ++i) { const int row = min(row0 + 8 * i, row_end - 1);
            a[i] = *(const u32x4*)(OF + (size_t)row * 512 + F.lane * 8); bq[i] = *(const u32x4*)(OB + (size_t)row * 512 + F.lane * 8); zz[i] = *(const u32x4*)(Z + (size_t)row * 512 + F.lane * 8); }
#pragma unroll
        for (int i = 0; i < 4; ++i) { const int row = row0 + 8 * i;
            if (row < row_end) {
                float o[8], z[8];
                o[0] = bflo(a[i].x) + bflo(bq[i].x); o[1] = bfhi(a[i].x) + bfhi(bq[i].x); o[2] = bflo(a[i].y) + bflo(bq[i].y); o[3] = bfhi(a[i].y) + bfhi(bq[i].y);
                o[4] = bflo(a[i].z) + bflo(bq[i].z); o[5] = bfhi(a[i].z) + bfhi(bq[i].z); o[6] = bflo(a[i].w) + bflo(bq[i].w); o[7] = bfhi(a[i].w) + bfhi(bq[i].w);
                z[0] = bflo(zz[i].x); z[1] = bfhi(zz[i].x); z[2] = bflo(zz[i].y); z[3] = bfhi(zz[i].y); z[4] = bflo(zz[i].z); z[5] = bfhi(zz[i].z); z[6] = bflo(zz[i].w); z[7] = bfhi(zz[i].w);
                float ss = 0.f;
#pragma unroll
                for (int j = 0; j < 8; ++j) ss += o[j] * o[j];
                ss += __shfl_xor(ss, 1); ss += __shfl_xor(ss, 2); ss += __shfl_xor(ss, 4); ss += __shfl_xor(ss, 8);
                const float rn = __builtin_amdgcn_rsqf(ss * (1.f / 128.f) + EPS);
                float y[8];
#pragma unroll
                for (int j = 0; j < 8; ++j) y[j] = o[j] * rn * g8[j] * siluf(z[j]);
                u32x4 w; w.x = cvtpk(y[0], y[1]); w.y = cvtpk(y[2], y[3]); w.z = cvtpk(y[4], y[5]); w.w = cvtpk(y[6], y[7]);
                *(u32x4*)(MIX + (size_t)row * D + F.lane * 8) = w;
            }
        }
    }
}

DI int dest_row(int kind, int n) {
    switch (kind) {
    case 1: {
        if (n < 2048) return n;
        if (n < 2064) return 2720 + (n - 2048);
        if (n < 2448) return 2048 + (n - 2064);
        if (n < 2704) return 2432 + (n - 2448);
        const int o = n - 2704, q = o >> 3, i = o & 7;
        return 2688 + ((q >> 1) * 16) + 2 * i + (q & 1);
    }
    case 2: {
        const int hd = n / 96, o = n % 96;
        if (o < 64) return n;
        const int oo = o - 64, q = oo >> 3, i = oo & 7;
        return hd * 96 + 64 + ((q >> 1) * 16) + 2 * i + (q & 1);
    }
    case 3: {
        const int hd = n >> 7, o = n & 127;
        return (o < 64 ? 0 : 512) + hd * 64 + (o & 63);
    }
    case 4: return (n >> 7) * 256 + (n & 127);
    case 5: return (n >> 7) * 256 + 128 + (n & 127);
    default: return n;
    }
}
DI void transpose_item(const float* W, int K, int N, bf16_t* WT, int ldk, int kind, LAS float* scr, int item, int lane, float scale = 1.f) {
    const int nblk = (N + 63) / 64, kb = item / nblk, nb = item % nblk, k0 = 64 * kb, n0 = 64 * nb;
    const float* src = W + (size_t)k0 * N + min(n0 + lane, N - 1);
    {
        float v[64];
        const float* sp = src;
#pragma unroll
        for (int i = 0; i < 64; ++i) { v[i] = __builtin_nontemporal_load(sp); sp += N; }
#pragma unroll
        for (int i = 0; i < 64; ++i) scr[i * 65 + lane] = v[i];
    }
    LDS_WAIT(); asm volatile("" ::: "memory");
    const int c = lane & 7;
    float tv[8][8];
#pragma unroll
    for (int j = 0; j < 8; ++j) { const LAS float* s = scr + (8 * c) * 65 + (lane >> 3) + 8 * j;
#pragma unroll
        for (int k = 0; k < 8; ++k) tv[j][k] = s[k * 65]; }
#pragma unroll
    for (int j = 0; j < 8; ++j)
#pragma unroll
        for (int k = 0; k < 8; ++k) asm volatile("" : "+v"(tv[j][k]));
#pragma unroll
    for (int j = 0; j < 8; ++j) { const int n = (lane >> 3) + 8 * j;
        u32x4 o; o.x = cvtpk(tv[j][0] * scale, tv[j][1] * scale); o.y = cvtpk(tv[j][2] * scale, tv[j][3] * scale); o.z = cvtpk(tv[j][4] * scale, tv[j][5] * scale); o.w = cvtpk(tv[j][6] * scale, tv[j][7] * scale);
        if (n0 + n < N) __builtin_nontemporal_store(o, (u32x4*)(WT + (size_t)dest_row(kind, n0 + n) * ldk + k0 + 8 * c)); }
    LDS_WAIT(); asm volatile("" ::: "memory");
}
DI void transpose_item8(const float* W, int K, int N, unsigned char* WT, int ldk, int kind, float scale, LAS float* scr, int item, int lane) {
    const int nblk = (N + 63) / 64, kb = item / nblk, nb = item % nblk, k0 = 64 * kb, n0 = 64 * nb;
    const float* src = W + (size_t)k0 * N + min(n0 + lane, N - 1);
    {
        float v[64];
        const float* sp = src;
#pragma unroll
        for (int i = 0; i < 64; ++i) { v[i] = __builtin_nontemporal_load(sp); sp += N; }
#pragma unroll
        for (int i = 0; i < 64; ++i) scr[i * 65 + lane] = v[i];
    }
    LDS_WAIT(); asm volatile("" ::: "memory");
    const int c = lane & 3;
    float tv[4][16];
#pragma unroll
    for (int j = 0; j < 4; ++j) { const LAS float* s = scr + (16 * c) * 65 + (lane >> 2) + 16 * j;
#pragma unroll
        for (int k = 0; k < 16; ++k) tv[j][k] = s[k * 65]; }
#pragma unroll
    for (int j = 0; j < 4; ++j)
#pragma unroll
        for (int k = 0; k < 16; ++k) asm volatile("" : "+v"(tv[j][k]));
#pragma unroll
    for (int j = 0; j < 4; ++j) { const int n = (lane >> 2) + 16 * j; const float* s = tv[j];
        u32x4 o; o.x = pg8::cvt4_fp8(s[0] * scale, s[1] * scale, s[2] * scale, s[3] * scale); o.y = pg8::cvt4_fp8(s[4] * scale, s[5] * scale, s[6] * scale, s[7] * scale);
        o.z = pg8::cvt4_fp8(s[8] * scale, s[9] * scale, s[10] * scale, s[11] * scale); o.w = pg8::cvt4_fp8(s[12] * scale, s[13] * scale, s[14] * scale, s[15] * scale);
        if (n0 + n < N) __builtin_nontemporal_store(o, (u32x4*)(WT + (size_t)dest_row(kind, n0 + n) * ldk + k0 + 16 * c)); }
    LDS_WAIT(); asm volatile("" ::: "memory");
}
struct CvtJob { const float* W; bf16_t* WT; int K, N, kind, items; };
DI void phase_p0(Frame& F) {
    __syncthreads();
    if (F.bid < 192) {
        LAS float* sv = (LAS float*)F.lds;
        LAS float* red = sv + 3 * 1024;
        for (int i = F.tid; i < 3 * 1024; i += 512) { const float v = i < 2048 ? F.in[1][i] : F.in[3][i - 2048]; sv[i] = siluf(v); }
        __syncthreads();
        const int layer = F.bid / 96, j0 = (F.bid % 96) * 64;
        const float* W = F.in[4] + (size_t)layer * D * 6144 + j0 + F.lane;
        float a0 = 0.f, a1 = 0.f, a2 = 0.f;
        const int kbeg = F.wave * 128;
#pragma unroll 32
        for (int k = kbeg; k < kbeg + 128; ++k) { const float w = W[(size_t)k * 6144]; a0 += sv[k] * w; a1 += sv[1024 + k] * w; a2 += sv[2048 + k] * w; }
        red[(F.wave * 3 + 0) * 64 + F.lane] = a0; red[(F.wave * 3 + 1) * 64 + F.lane] = a1; red[(F.wave * 3 + 2) * 64 + F.lane] = a2;
        __syncthreads();
        if (F.tid < 192) {
            const int r = F.tid >> 6, l = F.tid & 63; float s = 0.f;
#pragma unroll
            for (int w = 0; w < 8; ++w) s += red[(w * 3 + r) * 64 + l];
            ((float*)(F.ws + WS_MOD))[(size_t)(layer * 3 + r) * 6144 + j0 + l] = s + F.in[5][layer * 6144 + j0 + l];
        }
        __syncthreads();
    }
    {
        float* ROPE = (float*)(F.ws + WS_ROPE);
        for (int i = F.bid * 512 + F.tid; i < SEQ * 16; i += F.G * 512) {
            const int t = i >> 4, k = i & 15;
            const float pos = (float)((k < 8) ? (t >> 6) : (t & 63));
            const float inv = powf(10000.f, -(float)(2 * (k & 7)) / 16.f);
            const float ang = pos * inv;
            ROPE[i] = cosf(ang); ROPE[SEQ * 16 + i] = sinf(ang);
        }
    }
    LAS float* scr = (LAS float*)(F.lds + F.wave * 16640);
    const int gw = F.bid * 8 + F.wave, NGW = F.G * 8;
    unsigned char* ws = F.ws;
#define NITEMS(K, N) (((K) / 64) * (((N) + 63) / 64))
    int it = gw;
#define CVT(Wp, WTp, K, N, ldk, kind) do { const int ni = NITEMS(K, N); for (; it < ni; it += NGW) transpose_item((Wp), (K), (N), (WTp), (ldk), (kind), scr, it, F.lane); it -= ni; } while (0)
    CVT(F.in[7], (bf16_t*)(ws + WS_WIN), 1024, 2736, 1024, 1);
    CVT(F.in[13], (bf16_t*)(ws + WS_WUQ), 384, 768, 384, 2);
    CVT(F.in[15], (bf16_t*)(ws + WS_WUKV), 256, 1024, 256, 3);
#undef CVT
#undef NITEMS
}
DI void convert_experts(Frame& F, int gw, int NGW) {
    LAS float* scr = (LAS float*)(F.lds + F.wave * 16640);
    unsigned char* ws = F.ws;
#define NITEMS(K, N) (((K) / 64) * (((N) + 63) / 64))
#define CVT8(Wp, WTp, K, N, ldk, kind, sc) do { const int ni = NITEMS(K, N); for (; it < ni; it += NGW) transpose_item8((Wp), (K), (N), (WTp), (ldk), (kind), (sc), scr, it, F.lane); it -= ni; } while (0)
    int it = gw;
#define CVT(Wp, WTp, K, N, ldk, kind) do { const int ni = NITEMS(K, N); for (; it < ni; it += NGW) transpose_item((Wp), (K), (N), (WTp), (ldk), (kind), scr, it, F.lane, (kind) == 4 ? LOG2E : 1.f); it -= ni; } while (0)
    CVT(F.in[16], (bf16_t*)(ws + WS_WO0), 1024, 1024, 1024, 0);
    CVT(F.in[17], (bf16_t*)(ws + WS_WGU), 1024, 2816, 1024, 4);
    CVT(F.in[18], (bf16_t*)(ws + WS_WGU), 1024, 2816, 1024, 5);
    CVT8(F.in[19], ws + WS_WD, 2816, 1024, 2816, 0, 128.f);
#undef CVT
    CVT8(F.in[22], ws + WS_WO1, 1024, 1024, 1024, 0, 64.f);
    CVT8(F.in[20], ws + WS_WQK1, 1024, 3072, 1024, 0, 64.f);
    for (int e = 0; e < NE; ++e) {
        CVT8(F.in[24] + (size_t)e * D * DFE, ws + WS_WEGU + (size_t)e * 2 * DFE * D, 1024, 3584, 1024, 4, 64.f);
        CVT8(F.in[25] + (size_t)e * D * DFE, ws + WS_WEGU + (size_t)e * 2 * DFE * D, 1024, 3584, 1024, 5, 64.f);
        CVT8(F.in[26] + (size_t)e * DFE * D, ws + WS_WED + (size_t)e * D * DFE, 3584, 1024, 3584, 0, 128.f);
    }
#undef CVT8
#undef NITEMS
}


DI void phase_route(Frame& F, const float* xl) {
    const float* MOD = (const float*)(F.ws + WS_MOD) + (size_t)3 * 6144;
    const float* g = F.in[6] + (size_t)3 * D;
    const float* wr = F.in[23];
    unsigned char* Fb = F.ws + WS_F;
    int* tope = (int*)(F.ws + WS_ROUTE); float* topg = (float*)(F.ws + WS_ROUTE + 131072); int* slot = (int*)(F.ws + WS_ROUTE + 262144);
    unsigned* ecnt = F.ctl + CW_ECNT;
    const int lane = F.lane;
    const int gw = F.bid * 8 + F.wave, NGW = F.G * 8;
    f32x4 wq0[4][4], wq1[4][4];
#pragma unroll
    for (int j = 0; j < 4; ++j)
#pragma unroll
        for (int k = 0; k < 4; ++k) { const int col = 4 * lane + 256 * j + k; wq0[j][k] = *(const f32x4*)(wr + col * 8); wq1[j][k] = *(const f32x4*)(wr + col * 8 + 4); }
    int prow = -1, ps0 = 0, ps1 = 0;
    u32x2 nx[4];
    if (gw < ML) { const u32x2* xr = (const u32x2*)((const bf16_t*)xl + (size_t)gw * D) + lane;
#pragma unroll
        for (int j = 0; j < 4; ++j) nx[j] = xr[64 * j]; }
    for (int row = gw; row < ML; row += NGW) {
        const int r = row < SEQ ? 0 : 1;
        const float* mr = MOD + (size_t)r * 6144 + 3 * D;
        u32x2 cx[4];
#pragma unroll
        for (int j = 0; j < 4; ++j) cx[j] = nx[j];
        if (row + NGW < ML) { const u32x2* xn = (const u32x2*)((const bf16_t*)xl + (size_t)(row + NGW) * D) + lane;
#pragma unroll
            for (int j = 0; j < 4; ++j) nx[j] = xn[64 * j]; }
        f32x4 v[4]; float s = 0.f;
#pragma unroll
        for (int j = 0; j < 4; ++j) { const u32x2 a = cx[j]; v[j] = (f32x4){bflo(a.x), bfhi(a.x), bflo(a.y), bfhi(a.y)}; s += (v[j].x * v[j].x + v[j].y * v[j].y) + (v[j].z * v[j].z + v[j].w * v[j].w); }
        const float rs = __builtin_amdgcn_rsqf(wave_sum(s) * (1.f / D) + EPS);
        float lg[8];
#pragma unroll
        for (int e = 0; e < 8; ++e) lg[e] = 0.f;
        unsigned* o8 = (unsigned*)(Fb + (size_t)row * D) + lane;
        f32x4 gg_[4], cc_[4], hh_[4];
#pragma unroll
        for (int j = 0; j < 4; ++j) { gg_[j] = ((const f32x4*)g)[lane + 64 * j]; cc_[j] = ((const f32x4*)(mr + D))[lane + 64 * j]; hh_[j] = ((const f32x4*)mr)[lane + 64 * j]; }
#pragma unroll
        for (int j = 0; j < 4; ++j) {
            const f32x4 gg = gg_[j], cc = cc_[j], hh = hh_[j];
            f32x4 y;
#pragma unroll
            for (int k = 0; k < 4; ++k) {
                y[k] = v[j][k] * rs * gg[k] * (1.f + cc[k]) + hh[k];
                const f32x4 w0 = wq0[j][k], w1 = wq1[j][k];
                lg[0] += y[k] * w0[0]; lg[1] += y[k] * w0[1]; lg[2] += y[k] * w0[2]; lg[3] += y[k] * w0[3];
                lg[4] += y[k] * w1[0]; lg[5] += y[k] * w1[1]; lg[6] += y[k] * w1[2]; lg[7] += y[k] * w1[3];
            }
            o8[64 * j] = pg8::cvt4_fp8(y[0] * 8.f, y[1] * 8.f, y[2] * 8.f, y[3] * 8.f);
        }
#pragma unroll
        for (int e = 0; e < 8; ++e) lg[e] = wave_sum(lg[e]);
        int e0 = 0; float v0 = lg[0];
#pragma unroll
        for (int e = 1; e < 8; ++e) if (lg[e] > v0) { v0 = lg[e]; e0 = e; }
        int e1 = -1; float v1 = -3.0e38f;
#pragma unroll
        for (int e = 0; e < 8; ++e) if (e != e0 && lg[e] > v1) { v1 = lg[e]; e1 = e; }
        if (lane == 0) {
            const float p1 = __expf(v1 - v0), inv = 1.f / (1.f + p1);
            tope[row * 2] = e0; tope[row * 2 + 1] = e1; topg[row * 2] = inv; topg[row * 2 + 1] = p1 * inv;
            const int a0 = (int)atomicAdd(&ecnt[64 * e0], 1u), a1 = (int)atomicAdd(&ecnt[64 * e1], 1u);
            if (prow >= 0) { slot[prow * 2] = ps0; slot[prow * 2 + 1] = ps1; }
            prow = row; ps0 = a0; ps1 = a1;
        }
    }
    if (lane == 0 && prow >= 0) { slot[prow * 2] = ps0; slot[prow * 2 + 1] = ps1; }
}
DI void phase_scatter(Frame& F) {
    const unsigned char* Fb = F.ws + WS_F; unsigned char* FS = F.ws + WS_FS;
    const int* tope = (const int*)(F.ws + WS_ROUTE); const int* slot = (const int*)(F.ws + WS_ROUTE + 262144); int* pos = (int*)(F.ws + WS_ROUTE + 393216);
    const unsigned* ecnt = F.ctl + CW_ECNT;
    int off[8]; { int t = 0;
#pragma unroll
        for (int e = 0; e < 8; ++e) { off[e] = t; t += (((int)ecnt[64 * e] + 255) >> 8) << 8; } }
    const int gw = F.bid * 8 + F.wave, NGW = F.G * 8;
    for (int row0 = gw; row0 < ML; row0 += 4 * NGW) {
        u32x4 a[4]; int ee[4][2], ss[4][2];
#pragma unroll
        for (int i = 0; i < 4; ++i) { const int row = min(row0 + i * NGW, ML - 1);
            a[i] = *((const u32x4*)(Fb + (size_t)row * D) + F.lane);
#pragma unroll
            for (int k = 0; k < 2; ++k) { ee[i][k] = tope[row * 2 + k]; ss[i][k] = slot[row * 2 + k]; } }
#pragma unroll
        for (int i = 0; i < 4; ++i) { const int row = row0 + i * NGW;
            if (row < ML) {
#pragma unroll
                for (int k = 0; k < 2; ++k) {
                    const int e = ee[i][k]; int o = 0;
#pragma unroll
                    for (int q = 0; q < 8; ++q) o = (q == e) ? off[q] : o;
                    const int p = o + ss[i][k];
                    *((u32x4*)(FS + (size_t)p * D) + F.lane) = a[i];
                    if (F.lane == 0) pos[row * 2 + k] = p;
                }
            }
        }
    }
}
DI void phase_combine(Frame& F, const bf16_t* xl, float* outp) {
    const float* MOD = (const float*)(F.ws + WS_MOD) + (size_t)3 * 6144;
    const bf16_t* Y = (const bf16_t*)(F.ws + WS_FS);
    const float* topg = (const float*)(F.ws + WS_ROUTE + 131072); const int* pos = (const int*)(F.ws + WS_ROUTE + 393216);
    const float* fg = F.in[27];
    const bf16_t* PY = (const bf16_t*)(F.ws + WS_PARTY);
    int row0t; { pg8::MoeDownOrder S; S.init_down(F.ctl + CW_ECNT, F.G, 0); row0t = S.mt0 * 256; }
    const int lane = F.lane;
    const int gw = F.bid * 8 + F.wave, NGW = F.G * 8;
    int np0 = 0, np1 = 0; float nw0 = 0.f, nw1 = 0.f;
    if (gw < ML) { np0 = pos[gw * 2]; np1 = pos[gw * 2 + 1]; nw0 = topg[gw * 2]; nw1 = topg[gw * 2 + 1]; }
    for (int row = gw; row < ML; row += NGW) {
        const int r = row < SEQ ? 0 : 1;
        const float* g2 = MOD + (size_t)r * 6144 + 5 * D;
        const int p0 = __builtin_amdgcn_readfirstlane(np0), p1 = __builtin_amdgcn_readfirstlane(np1); const float w0 = nw0, w1 = nw1;
        { const int nr = min(row + NGW, ML - 1); np0 = pos[nr * 2]; np1 = pos[nr * 2 + 1]; nw0 = topg[nr * 2]; nw1 = topg[nr * 2 + 1]; }
        const u32x2* xr = (const u32x2*)(xl + (size_t)row * D) + lane; f32x4* orow = (f32x4*)(outp + (size_t)row * D) + lane;
        u32x2 xraw[4], ra[2][4], rb[2][4]; float wb[2];
#pragma unroll
        for (int j = 0; j < 4; ++j) xraw[j] = xr[64 * j];
#pragma unroll
        for (int k = 0; k < 2; ++k) {
            const int pp = k ? p1 : p0; const bool tail = pp >= row0t;
            const u32x2* ypa = (const u32x2*)(tail ? PY + (size_t)(pp - row0t) * D : Y + (size_t)pp * D) + lane;
            const u32x2* ypb = tail ? ypa + (size_t)(2048 * 1024 / 4) : ypa;
            wb[k] = tail ? 1.f : 0.f;
#pragma unroll
            for (int j = 0; j < 4; ++j) { ra[k][j] = ypa[64 * j]; rb[k][j] = ypb[64 * j]; }
        }
        f32x4 ya[4], yb[4];
#pragma unroll
        for (int j = 0; j < 4; ++j) {
            ya[j] = (f32x4){bflo(ra[0][j].x), bfhi(ra[0][j].x), bflo(ra[0][j].y), bfhi(ra[0][j].y)} + wb[0] * (f32x4){bflo(rb[0][j].x), bfhi(rb[0][j].x), bflo(rb[0][j].y), bfhi(rb[0][j].y)};
            yb[j] = (f32x4){bflo(ra[1][j].x), bfhi(ra[1][j].x), bflo(ra[1][j].y), bfhi(ra[1][j].y)} + wb[1] * (f32x4){bflo(rb[1][j].x), bfhi(rb[1][j].x), bflo(rb[1][j].y), bfhi(rb[1][j].y)};
        }
        f32x4 v[4]; float s = 0.f;
#pragma unroll
        for (int j = 0; j < 4; ++j) {
            const u32x2 xa = xraw[j]; const f32x4 x = (f32x4){bflo(xa.x), bfhi(xa.x), bflo(xa.y), bfhi(xa.y)}, gg = ((const f32x4*)g2)[lane + 64 * j];
            v[j] = x + gg * (w0 * ya[j] + w1 * yb[j]);
            s += (v[j].x * v[j].x + v[j].y * v[j].y) + (v[j].z * v[j].z + v[j].w * v[j].w);
        }
        const float rs = __builtin_amdgcn_rsqf(wave_sum(s) * (1.f / D) + EPS);
        f32x4 fg_[4];
#pragma unroll
        for (int j = 0; j < 4; ++j) fg_[j] = ((const f32x4*)fg)[lane + 64 * j];
#pragma unroll
        for (int j = 0; j < 4; ++j) __builtin_nontemporal_store(v[j] * rs * fg_[j], orow + 64 * j);
    }
}

constexpr int NPHASE = 20;
constexpr int NCVT_WG = 48;
#ifndef PROBE_PH
#define PROBE_PH -1
#endif
#define REPS(k) ((PROBE_PH == (k)) ? 2 : 1)
struct Args { const float* in[28]; float* out; unsigned char* ws; int ph_lo, ph_hi; };
__global__ void __launch_bounds__(512, 2) fwd_kernel(Args a) {
    extern __shared__ __attribute__((aligned(16))) unsigned char lds_raw[];
    Frame F;
    F.lds = (LAS unsigned char*)lds_raw;
    F.MISC = (volatile LAS unsigned*)(F.lds + MISC_OFF);
    F.tid = threadIdx.x; F.lane = F.tid & 63; F.wave = __builtin_amdgcn_readfirstlane(F.tid >> 6);
    F.G = gridDim.x; F.bid = blockIdx.x;
    F.ws = a.ws; F.ctl = (unsigned*)(a.ws + WS_CTL); F.out = a.out;
    F.in = a.in;
    if (F.tid < 128) F.MISC[F.tid] = 0u;
    __syncthreads();
    XcdBarrier bar = xcd_barrier_post(F.ctl + CW_BAR, F.MISC + 8);
    const int lo = a.ph_lo, hi = a.ph_hi;
#define IN(k) (lo <= (k) && (k) < hi)
#define SEAM(k) do { if (IN(k) && IN((k) + 1)) xcd_barrier(bar); } while (0)
    unsigned char* ws = a.ws;
    bf16_t* XLB = (bf16_t*)(ws + WS_XLB); float* XC = (float*)(ws + WS_XC);
    bf16_t* H = (bf16_t*)(ws + WS_H);
    const float* MOD0 = (const float*)(ws + WS_MOD); const float* MOD1 = MOD0 + 3 * 6144;
    LAS unsigned char* ring = F.lds;

    if (IN(0)) { for (int rep = 0; rep < REPS(0); ++rep) phase_p0(F); }
    SEAM(0);
    if (IN(1)) phase_norm_mod(F, F.in[0], F.in[2], MT, 0, 0, H, nullptr, 0, nullptr, nullptr);
    SEAM(1);
    if (IN(2)) {
        pg8::Gemm g{H, (const bf16_t*)(ws + WS_WIN), 1024, 1024, 1024, 0};
        pg8::StaticOrder S; S.init(MT, NPROJ, F.G, F.bid);
        pg8::EpiWin E{(bf16_t*)(ws + WS_QKVP), (bf16_t*)(ws + WS_Z), (bf16_t*)(ws + WS_CQKV), (float*)(ws + WS_AB)};
        pg8::gemm_phase(ring, g, S, E);
    }
    SEAM(2);
    if (IN(3)) phase_prep(F);
    SEAM(3);
    if (IN(4)) {
        { pg8::Gemm g{(const bf16_t*)(ws + WS_CQKV), (const bf16_t*)(ws + WS_WUQ), 768, 384, 384, 0};
          pg8::StaticOrder S; S.init(MT, 768, F.G, F.bid);
          pg8::EpiBf16 E{(bf16_t*)(ws + WS_MLAQ), 768};
          pg8::gemm_phase(ring, g, S, E); }
        { pg8::Gemm g{(const bf16_t*)(ws + WS_CQKV) + 384, (const bf16_t*)(ws + WS_WUKV), 768, 256, 256, 0};
          pg8::StaticOrder S; S.init(MT, 512, F.G, F.bid);
          pg8::EpiBf16 E{(bf16_t*)(ws + WS_KN), 512};
          pg8::gemm_phase(ring, g, S, E); }
        { pg8::Gemm g{(const bf16_t*)(ws + WS_WUKV) + (size_t)512 * 256, (const bf16_t*)(ws + WS_CQKV) + 384, 256, 768, 256, 0};
          pg8::StaticOrder S; S.init(512, MT, F.G, F.bid);
          pg8::EpiBf16 E{(bf16_t*)(ws + WS_VT), MT};
          pg8::gemm_phase(ring, g, S, E); }
#define GQOFF 0
        {
            __syncthreads();
            if (F.tid == 0) F.MISC[0] = atomicAdd(F.ctl + CW_GDNQ + GQOFF, 1u);
            __syncthreads();
            int u = (int)F.MISC[0];
            while (u < NB * 4 * NCHUNK) {
                unsigned nxt_ = 0u;
                if (F.tid == 0) nxt_ = atomicAdd(F.ctl + CW_GDNQ + GQOFF, 1u);
                gdn_chunk_unit(F, u);
                __syncthreads();
                if (F.tid == 0) F.MISC[0] = nxt_;
                __syncthreads();
                u = (int)F.MISC[0];
            }
        }
#undef GQOFF
    }
#if PROBE_PH == 4
    if (IN(4)) {
        { pg8::Gemm g{(const bf16_t*)(ws + WS_CQKV), (const bf16_t*)(ws + WS_WUQ), 768, 384, 384, 0};
          pg8::StaticOrder S; S.init(MT, 768, F.G, F.bid);
          pg8::EpiBf16 E{(bf16_t*)(ws + WS_MLAQ), 768};
          pg8::gemm_phase(ring, g, S, E); }
        { pg8::Gemm g{(const bf16_t*)(ws + WS_CQKV) + 384, (const bf16_t*)(ws + WS_WUKV), 768, 256, 256, 0};
          pg8::StaticOrder S; S.init(MT, 512, F.G, F.bid);
          pg8::EpiBf16 E{(bf16_t*)(ws + WS_KN), 512};
          pg8::gemm_phase(ring, g, S, E); }
        { pg8::Gemm g{(const bf16_t*)(ws + WS_WUKV) + (size_t)512 * 256, (const bf16_t*)(ws + WS_CQKV) + 384, 256, 768, 256, 0};
          pg8::StaticOrder S; S.init(512, MT, F.G, F.bid);
          pg8::EpiBf16 E{(bf16_t*)(ws + WS_VT), MT};
          pg8::gemm_phase(ring, g, S, E); }
#define GQOFF 64
        for (;;) {
            __syncthreads();
            if (F.tid == 0) F.MISC[0] = atomicAdd(F.ctl + CW_GDNQ + GQOFF, 1u);
            __syncthreads();
            const int u = (int)F.MISC[0];
            if (u >= NB * 4 * NCHUNK) break;
            gdn_chunk_unit(F, u);
        }
#undef GQOFF
    }
#endif
    SEAM(4);
#define QOFF 0
    if (IN(5)) {
        if (F.bid < 16) {
            gdn_scan(F, F.bid);
            asm volatile("s_waitcnt vmcnt(0)" ::: "memory"); __syncthreads();
            if (F.tid == 0 && QOFF == 0) { __builtin_amdgcn_fence(__ATOMIC_RELEASE, "agent"); asm volatile("s_waitcnt vmcnt(0)" ::: "memory"); (void)xb_add(F.ctl + CW_SCANDONE, 1u); }
        }
        else if (F.bid < 16 + NCVT_WG && QOFF == 0) { __syncthreads(); convert_experts(F, (F.bid - 16) * 8 + F.wave, NCVT_WG * 8); __syncthreads(); }
        {
            __syncthreads();
            if (F.tid == 0) F.MISC[0] = atomicAdd(F.ctl + CW_QUEUE + QOFF, 1u);
            __syncthreads();
            int u = (int)F.MISC[0];
            while (u < 1056) {
                unsigned nxt_ = 0u;
                if (F.tid == 0) nxt_ = atomicAdd(F.ctl + CW_QUEUE + QOFF, 1u);
                if (u < 1024) mla_unit(F, u >> 9, (u >> 6) & 7, u & 63);
                else mla_unit(F, (u - 1024) >> 4, ((u - 1024) >> 1) & 7, -1 - ((u - 1024) & 1));
                __syncthreads();
                if (F.tid == 0) F.MISC[0] = nxt_;
                __syncthreads();
                u = (int)F.MISC[0];
            }
        }
        {
            __syncthreads();
            if (F.tid == 0) { unsigned* sd = F.ctl + CW_SCANDONE; XB_SPIN(xb_ld(sd) < 16u, F.ctl + CW_BAR); __builtin_amdgcn_fence(__ATOMIC_ACQUIRE, "agent"); asm volatile("s_waitcnt vmcnt(0)" ::: "memory"); }
            __syncthreads();
            for (;;) {
                __syncthreads();
                if (F.tid == 0) F.MISC[0] = atomicAdd(F.ctl + CW_GOQ, 1u);
                __syncthreads();
                const int it = (int)F.MISC[0];
                if (it >= MT / 64) break;
                gdn_out_rows(F, it * 64, it * 64 + 64);
            }
        }
    }
#undef QOFF
#if PROBE_PH == 5
#define QOFF 64
    if (IN(5)) {
        if (F.bid < 16) {
            gdn_scan(F, F.bid);
            asm volatile("s_waitcnt vmcnt(0)" ::: "memory"); __syncthreads();
            if (F.tid == 0 && QOFF == 0) { __builtin_amdgcn_fence(__ATOMIC_RELEASE, "agent"); asm volatile("s_waitcnt vmcnt(0)" ::: "memory"); (void)xb_add(F.ctl + CW_SCANDONE, 1u); }
        }
        else if (F.bid < 16 + NCVT_WG && QOFF == 0) { __syncthreads(); convert_experts(F, (F.bid - 16) * 8 + F.wave, NCVT_WG * 8); __syncthreads(); }
        for (;;) {
            __syncthreads();
            if (F.tid == 0) F.MISC[0] = atomicAdd(F.ctl + CW_QUEUE + QOFF, 1u);
            __syncthreads();
            const int u = (int)F.MISC[0];
            if (u >= 1056) break;
            if (u < 1024) mla_unit(F, u >> 9, (u >> 6) & 7, u & 63);
            else mla_unit(F, (u - 1024) >> 4, ((u - 1024) >> 1) & 7, -1 - ((u - 1024) & 1));
        }
    }
#undef QOFF
#endif
    SEAM(5);
    if (IN(7)) {
        { pg8::Gemm g{H, (const bf16_t*)(ws + WS_WO0), 1024, 1024, 1024, 0, 0};
          pg8::StaticOrder S; S.init(ML, 1024, F.G, F.bid);
          pg8::EpiResidB<true> E{F.in[0], XLB, MOD0 + 2 * D, 1.f};
          pg8::gemm_phase<false, true>(ring, g, S, E); }
        { pg8::Gemm g{H + (size_t)ML * D, (const bf16_t*)(ws + WS_WO0), 1024, 1024, 256, 512, 512};
          pg8::SplitKOrder S; S.init(4, F.G, (F.bid + 128) % F.G);
          pg8::EpiPartial E{(float*)(ws + WS_PART), 1.f};
          pg8::gemm_phase(ring, g, S, E); }
    }
    SEAM(7);
    if (IN(8)) phase_norm_mod<true>(F, (const float*)XLB, F.in[2], MT, 0, 1, H, (const float*)(ws + WS_PART), 4, MOD0 + 2 * 6144 + 2 * D, XC);
    SEAM(8);
    if (IN(9)) {
        pg8::Gemm g{H, (const bf16_t*)(ws + WS_WGU), 1024, 1024, 1024, 0};
        pg8::StaticOrder S; S.init(MT, 2 * DFF, F.G, F.bid);
        pg8::EpiSwigluQ8 E{ws + WS_ACT, DFF};
        pg8::gemm_phase(ring, g, S, E);
    }
    SEAM(9);
    if (IN(10)) {
        { pg8::Gemm g{(const bf16_t*)(ws + WS_ACT), (const bf16_t*)(ws + WS_WD), DFF, DFF, DFF, 0, 0};
          pg8::StaticOrder S; S.init(ML, 1024, F.G, F.bid);
          pg8::EpiResidB<false> E{XLB, XLB, MOD0 + 5 * D, 1.f / 1024.f};
          pg8::gemm_phase<true, true>(ring, g, S, E); }
        { pg8::Gemm g{(const bf16_t*)(ws + WS_ACT + (size_t)ML * DFF), (const bf16_t*)(ws + WS_WD), DFF, DFF, 256, 256, 256};
          pg8::SplitKOrder S; S.init(11, F.G, (F.bid + 128) % F.G);
          pg8::EpiPartial E{(float*)(ws + WS_PART), 1.f / 1024.f};
          pg8::gemm_phase<true>(ring, g, S, E); }
    }
    SEAM(10);
    if (IN(11)) phase_norm_mod<true, true>(F, (const float*)XLB, XC, MT, 1, 0, H, (const float*)(ws + WS_PART), 11, MOD0 + 2 * 6144 + 5 * D, nullptr);
    SEAM(11);
    if (IN(12)) {
        const bf16_t* H8 = H; const bf16_t* W8 = (const bf16_t*)(ws + WS_WQK1);
        { pg8::Gemm g{H8, W8, 1024, 1024, 1024, 0, 0};
          pg8::StaticOrder S; S.init(ML, 2048, F.G, F.bid);
          pg8::EpiBf16S E{(bf16_t*)(ws + WS_QK1), 2048, 1.f / 512.f};
          pg8::gemm_phase<true>(ring, g, S, E); }
        { pg8::Gemm g{(const bf16_t*)((const unsigned char*)W8 + (size_t)2048 * 1024), H8, 1024, 1024, 1024, 0, 0};
          pg8::StaticOrder S; S.init(1024, ML, F.G, F.bid);
          pg8::EpiBf16S E{(bf16_t*)(ws + WS_VT1), MT, 1.f / 512.f};
          pg8::gemm_phase<true>(ring, g, S, E); }
        { pg8::Gemm g{(const bf16_t*)((const unsigned char*)H8 + (size_t)ML * 1024), (const bf16_t*)((const unsigned char*)W8 + (size_t)1024 * 1024), 1024, 1024, 1024, 0, 0};
          pg8::StaticOrder S; S.init(MC, 1024, F.G, (F.bid + 64) % F.G);
          pg8::EpiBf16S E{(bf16_t*)(ws + WS_QK1) + (size_t)ML * 2048 + 1024, 2048, 1.f / 512.f};
          pg8::gemm_phase<true>(ring, g, S, E); }
        { pg8::Gemm g{(const bf16_t*)((const unsigned char*)W8 + (size_t)2048 * 1024), (const bf16_t*)((const unsigned char*)H8 + (size_t)ML * 1024), 1024, 1024, 1024, 0, 0};
          pg8::StaticOrder S; S.init(1024, MC, F.G, (F.bid + 192) % F.G);
          pg8::EpiBf16S E{(bf16_t*)(ws + WS_VT1) + ML, MT, 1.f / 512.f};
          pg8::gemm_phase<true>(ring, g, S, E); }
    }
    SEAM(12);
    if (IN(13)) { for (int rep = 0; rep < REPS(13); ++rep) for (int u = F.bid; u < 1024; u += F.G) na_unit(F, u >> 9, (u >> 5) & 15, u & 31); }
    SEAM(13);
    if (IN(14)) {
        pg8::Gemm g{(const bf16_t*)(ws + WS_O1), (const bf16_t*)(ws + WS_WO1), 1024, 1024, 1024, 0, 0};
        pg8::StaticOrder S; S.init(ML, 1024, F.G, F.bid);
        pg8::EpiResidB<false> E{XLB, XLB, MOD1 + 2 * D, 1.f / 512.f};
        pg8::gemm_phase<true, true>(ring, g, S, E);
    }
    SEAM(14);
    if (IN(15)) phase_route(F, (const float*)XLB);
    SEAM(15);
    if (IN(16)) phase_scatter(F);
    SEAM(16);
    if (IN(17)) {
        pg8::Gemm g{(const bf16_t*)(ws + WS_FS), (const bf16_t*)(ws + WS_WEGU), 1024, 1024, 1024, (size_t)2 * DFE * D, 0};
        pg8::MoeOrder S; S.init_moe(F.ctl + CW_ECNT, 2 * DFE, F.G, F.bid);
        pg8::EpiSwigluF8 E{ws + WS_ACTS, DFE, 1.f / 512.f, 8.f};
        pg8::gemm_phase<true>(ring, g, S, E);
    }
#if PROBE_PH == 17
    if (IN(17)) {
        pg8::Gemm g{(const bf16_t*)(ws + WS_FS), (const bf16_t*)(ws + WS_WEGU), 1024, 1024, 1024, (size_t)2 * DFE * D, 0};
        pg8::MoeOrder S; S.init_moe(F.ctl + CW_ECNT, 2 * DFE, F.G, F.bid);
        pg8::EpiSwigluF8 E{ws + WS_ACTS, DFE, 1.f / 512.f, 8.f};
        pg8::gemm_phase<true>(ring, g, S, E);
    }
#endif
    SEAM(17);
    if (IN(18)) {
        { pg8::Gemm g{(const bf16_t*)(ws + WS_ACTS), (const bf16_t*)(ws + WS_WED), DFE, DFE, DFE, (size_t)D * DFE, 0};
          pg8::MoeDownOrder S; S.init_down(F.ctl + CW_ECNT, F.G, F.bid);
          pg8::EpiBf16S E{(bf16_t*)(ws + WS_FS), 1024, 1.f / 1024.f};
          pg8::gemm_phase<true>(ring, g, S, E); }
        { pg8::Gemm g{(const bf16_t*)(ws + WS_ACTS), (const bf16_t*)(ws + WS_WED), DFE, DFE, 1792, (size_t)D * DFE, 0};
          pg8::MoeTailOrder S; S.init_down(F.ctl + CW_ECNT, F.G, (F.bid + 128) % F.G);
          pg8::EpiMoeTail E{(bf16_t*)(ws + WS_PARTY), S.mt0 * 256, 1.f / 1024.f};
          pg8::gemm_phase<true>(ring, g, S, E); }
    }
#if PROBE_PH == 18
    if (IN(18)) {
        { pg8::Gemm g{(const bf16_t*)(ws + WS_ACTS), (const bf16_t*)(ws + WS_WED), DFE, DFE, DFE, (size_t)D * DFE, 0};
          pg8::MoeDownOrder S; S.init_down(F.ctl + CW_ECNT, F.G, F.bid);
          pg8::EpiBf16S E{(bf16_t*)(ws + WS_FS), 1024, 1.f / 1024.f};
          pg8::gemm_phase<true>(ring, g, S, E); }
        { pg8::Gemm g{(const bf16_t*)(ws + WS_ACTS), (const bf16_t*)(ws + WS_WED), DFE, DFE, 1792, (size_t)D * DFE, 0};
          pg8::MoeTailOrder S; S.init_down(F.ctl + CW_ECNT, F.G, (F.bid + 128) % F.G);
          pg8::EpiMoeTail E{(bf16_t*)(ws + WS_PARTY), S.mt0 * 256, 1.f / 1024.f};
          pg8::gemm_phase<true>(ring, g, S, E); }
    }
#endif
    SEAM(18);
    if (IN(19)) phase_combine(F, XLB, a.out);
#undef IN
#undef SEAM
}

#ifndef MK_MULTI
#define MK_MULTI 0
#endif
extern "C" void kernel_launch(void* const* d_in, const int* in_sizes, int n_in, void* d_out, int out_size, void* d_ws, size_t ws_size, hipStream_t stream) {
    static int grid = 0;
    if (grid == 0) {
        if (n_in != 28 || out_size != ML * D || ws_size < WS_END) { fprintf(stderr, "kernel_launch: unexpected shapes (n_in %d out %d ws %zu need %zu)\n", n_in, out_size, ws_size, (size_t)WS_END); grid = -1; return; }
        int dev = 0, cus = 0, per_cu = 0;
        if (hipGetDevice(&dev) != hipSuccess || hipDeviceGetAttribute(&cus, hipDeviceAttributeMultiprocessorCount, dev) != hipSuccess) { grid = -1; return; }
        if (hipFuncSetAttribute((const void*)fwd_kernel, hipFuncAttributeMaxDynamicSharedMemorySize, LDS_BYTES) != hipSuccess) { fprintf(stderr, "kernel_launch: hipFuncSetAttribute failed\n"); grid = -1; return; }
        if (hipOccupancyMaxActiveBlocksPerMultiprocessor(&per_cu, (const void*)fwd_kernel, 512, LDS_BYTES) != hipSuccess || per_cu < 1) { fprintf(stderr, "kernel_launch: occupancy query says %d\n", per_cu); }
        (void)hipGetLastError();
        grid = cus;
        if (grid < 128) { grid = -1; return; }
    }
    if (grid < 0) return;
    (void)hipMemsetAsync((char*)d_ws + WS_CTL, 0, CTL_BYTES, stream);
    Args a{};
    for (int i = 0; i < 28; ++i) a.in[i] = (const float*)d_in[i];
    a.out = (float*)d_out; a.ws = (unsigned char*)d_ws;
#if MK_MULTI
    for (int p = 0; p < NPHASE; ++p) { a.ph_lo = p; a.ph_hi = p + 1; hipLaunchKernelGGL(fwd_kernel, dim3(grid), dim3(512), LDS_BYTES, stream, a); }
#else
    a.ph_lo = 0; a.ph_hi = NPHASE;
    hipLaunchKernelGGL(fwd_kernel, dim3(grid), dim3(512), LDS_BYTES, stream, a);
#endif
}
```
